# Optimizing an MI355X kernel written in HIP

```python
import math
import jax, jax.numpy as jnp
from jax import lax
import numpy as np

D_MODEL = 1024
BATCH = 16
SEQ = 4096
DEPTH = 1

ATT_HEADS = 8
ATT_KV_HEADS = 2
ATT_HEAD_DIM = 64
ROT_DIM = ATT_HEAD_DIM // 4
ROPE_THETA = 500000.0
WINDOW = 128
ATT_BLOCK = 128
HG_HEADS = 4
HG_DIM = 128
HG_CHUNK = 64
ATT_WIDTH = ATT_HEADS * ATT_HEAD_DIM
KV_WIDTH = ATT_KV_HEADS * ATT_HEAD_DIM
HG_WIDTH = HG_HEADS * HG_DIM
MIX_WIDTH = ATT_WIDTH + HG_WIDTH
IN_SIZES = (ATT_WIDTH, KV_WIDTH, KV_WIDTH, HG_WIDTH, HG_WIDTH, HG_WIDTH, HG_WIDTH, HG_WIDTH)
IN_WIDTH = ATT_WIDTH + 2 * KV_WIDTH + 5 * HG_WIDTH
D_FF = 2816
FFN_RES_WEIGHT = 0.5
EPS = 1e-6
NEG_INF = -1e30

kernel_name = "hymba_swa_hgrn2_macaron_encoder"


def rmsnorm(x, w):
    xf = x.astype(jnp.float32)
    y = xf * lax.rsqrt(jnp.mean(xf * xf, axis=-1, keepdims=True) + EPS)
    return (y * w.astype(jnp.float32)).astype(x.dtype)


def swiglu(x, w_gate, w_up, w_down):
    return (jax.nn.silu(x @ w_gate) * (x @ w_up)) @ w_down


def partial_rope(t, pos):
    half = ROT_DIM // 2
    inv_freq = jnp.exp(-math.log(ROPE_THETA) * jnp.arange(half, dtype=jnp.float32) * 2.0 / ROT_DIM)
    ang = pos[:, None] * inv_freq[None, :]
    cos = jnp.cos(ang)[None, :, None, :]
    sin = jnp.sin(ang)[None, :, None, :]
    tf = t.astype(jnp.float32)
    t1, t2, rest = tf[..., :half], tf[..., half:ROT_DIM], tf[..., ROT_DIM:]
    return jnp.concatenate([t1 * cos - t2 * sin, t2 * cos + t1 * sin, rest], axis=-1).astype(t.dtype)


def windowed_gqa_sink(q, k, v, sink):
    B, S = q.shape[0], q.shape[1]
    nb = S // ATT_BLOCK
    G = ATT_HEADS // ATT_KV_HEADS
    qb = q.reshape(B, nb, ATT_BLOCK, ATT_KV_HEADS, G, ATT_HEAD_DIM)
    pad = ((0, 0), (ATT_BLOCK, ATT_BLOCK), (0, 0), (0, 0))
    kp = jnp.pad(k, pad).reshape(B, nb + 2, ATT_BLOCK, ATT_KV_HEADS, ATT_HEAD_DIM)
    vp = jnp.pad(v, pad).reshape(B, nb + 2, ATT_BLOCK, ATT_KV_HEADS, ATT_HEAD_DIM)

    def band(t):
        return jnp.concatenate([t[:, :-2], t[:, 1:-1], t[:, 2:]], axis=2)

    kb, vb = band(kp), band(vp)
    blk = jnp.arange(nb)
    q_pos = blk[:, None, None] * ATT_BLOCK + jnp.arange(ATT_BLOCK)[None, :, None]
    k_pos = blk[:, None, None] * ATT_BLOCK - ATT_BLOCK + jnp.arange(3 * ATT_BLOCK)[None, None, :]
    valid = (k_pos >= 0) & (k_pos < S) & (jnp.abs(k_pos - q_pos) <= WINDOW)
    sink_f = sink.astype(jnp.float32).reshape(ATT_KV_HEADS, G)[None, :, :, None, None]
    scale = ATT_HEAD_DIM ** -0.5

    def one_block(args):
        qn, kn, vn, mn = args
        s = jnp.einsum('bqhgd,bkhd->bhgqk', qn, kn).astype(jnp.float32) * scale
        s = jnp.where(mn, s, NEG_INF)
        m = jnp.maximum(jnp.max(s, axis=-1, keepdims=True), sink_f)
        p = jnp.exp(s - m)
        p = p / (jnp.sum(p, axis=-1, keepdims=True) + jnp.exp(sink_f - m))
        return jnp.einsum('bhgqk,bkhd->bqhgd', p.astype(vn.dtype), vn)

    o = lax.map(one_block, (jnp.moveaxis(qb, 1, 0), jnp.moveaxis(kb, 1, 0), jnp.moveaxis(vb, 1, 0), valid))
    return jnp.moveaxis(o, 0, 1).reshape(B, S, ATT_WIDTH)


def gla_chunk_scan(q, k, v, log_f):
    B, S, H, DK = q.shape
    DV = v.shape[-1]
    n = S // HG_CHUNK

    def chunks(t):
        return t.reshape(B, n, HG_CHUNK, H, t.shape[-1]).transpose(1, 0, 3, 2, 4)

    mask = jnp.tril(jnp.ones((HG_CHUNK, HG_CHUNK), dtype=bool))[:, :, None]

    def step(state, xs):
        qc, kc, vc, gc = xs
        b = jnp.cumsum(gc, axis=2)
        decay = jnp.exp(jnp.where(mask, b[:, :, :, None, :] - b[:, :, None, :, :], NEG_INF))
        scores = jnp.einsum('bhtsk,bhsk->bhts', qc[:, :, :, None, :] * decay, kc)
        o = (jnp.einsum('bhts,bhsv->bhtv', scores, vc)
             + jnp.einsum('bhtk,bhkv->bhtv', qc * jnp.exp(b), state))
        b_last = b[:, :, -1:, :]
        state = (state * jnp.exp(b_last)[:, :, 0, :, None]
                 + jnp.einsum('bhsk,bhsv->bhkv', kc * jnp.exp(b_last - b), vc))
        return state, o

    state0 = jnp.zeros((B, H, DK, DV), jnp.float32)
    _, o = lax.scan(step, state0, (chunks(q), chunks(k), chunks(v), chunks(log_f)))
    return o.transpose(1, 0, 3, 2, 4).reshape(B, S, H, DV)


def hgrn2_direction(q, v, f_logit, lb):
    f = lb + (1.0 - lb) * jax.nn.sigmoid(f_logit)
    return gla_chunk_scan(q, 1.0 - f, v, jnp.log(f))


def layer_lower_bound(lb_raw, layer):
    return jnp.cumsum(jax.nn.softmax(lb_raw.astype(jnp.float32), axis=0), axis=0)[layer]


def hybrid_mixer(u, w_in, attn_sink, attn_out_norm, lb_fwd, lb_bwd, hg_out_norm, w_out, layer):
    B, S, _ = u.shape
    proj = u @ w_in
    cuts, acc = [], 0
    for size in IN_SIZES[:-1]:
        acc += size
        cuts.append(acc)
    q, k, v, hq, hf_fwd, hf_bwd, hi, hg = jnp.split(proj, cuts, axis=-1)

    pos = jnp.arange(S, dtype=jnp.float32)
    q = partial_rope(q.reshape(B, S, ATT_HEADS, ATT_HEAD_DIM), pos)
    k = partial_rope(k.reshape(B, S, ATT_KV_HEADS, ATT_HEAD_DIM), pos)
    v = v.reshape(B, S, ATT_KV_HEADS, ATT_HEAD_DIM)
    att = rmsnorm(windowed_gqa_sink(q, k, v, attn_sink), attn_out_norm)

    heads = lambda t: t.reshape(B, S, HG_HEADS, HG_DIM).astype(jnp.float32)
    qh = jax.nn.sigmoid(heads(hq))
    vh = jax.nn.silu(heads(hi))
    lbf = layer_lower_bound(lb_fwd, layer).reshape(HG_HEADS, HG_DIM)
    lbb = layer_lower_bound(lb_bwd, layer).reshape(HG_HEADS, HG_DIM)
    o_fwd = hgrn2_direction(qh, vh, heads(hf_fwd), lbf)
    flip = lambda t: jnp.flip(t, axis=1)
    o_bwd = flip(hgrn2_direction(flip(qh), flip(vh), flip(heads(hf_bwd)), lbb))
    o = rmsnorm(o_fwd + o_bwd, hg_out_norm) * jax.nn.silu(heads(hg))
    hgo = o.reshape(B, S, HG_WIDTH).astype(u.dtype)

    return jnp.concatenate([att, hgo], axis=-1) @ w_out


def setup_inputs(seed: int = 0) -> dict:
    key = jax.random.key(seed)
    ks = jax.random.split(key, 24)
    f32 = jnp.float32

    def w(k, shape, fan_in):
        return jax.random.normal(k, shape, f32) * (fan_in ** -0.5)

    def gain(k, shape):
        return 1.0 + 0.02 * jax.random.normal(k, shape, f32)

    return {
        "x": jax.random.normal(ks[0], (BATCH, SEQ, D_MODEL), f32),
        "ffn1_pre_norm": gain(ks[1], (DEPTH, D_MODEL)),
        "ffn1_post_norm": gain(ks[2], (DEPTH, D_MODEL)),
        "ffn1_w_gate": w(ks[3], (DEPTH, D_MODEL, D_FF), D_MODEL),
        "ffn1_w_up": w(ks[4], (DEPTH, D_MODEL, D_FF), D_MODEL),
        "ffn1_w_down": w(ks[5], (DEPTH, D_FF, D_MODEL), D_FF),
        "mix_pre_norm": gain(ks[6], (DEPTH, D_MODEL)),
        "mix_post_norm": gain(ks[7], (DEPTH, D_MODEL)),
        "w_in": w(ks[8], (DEPTH, D_MODEL, IN_WIDTH), D_MODEL),
        "attn_sink": 0.5 * jax.random.normal(ks[9], (DEPTH, ATT_HEADS), f32),
        "attn_out_norm": gain(ks[10], (DEPTH, ATT_WIDTH)),
        "hgrn_lb_fwd": 0.1 * jax.random.normal(ks[11], (DEPTH + 1, HG_WIDTH), f32),
        "hgrn_lb_bwd": 0.1 * jax.random.normal(ks[12], (DEPTH + 1, HG_WIDTH), f32),
        "hgrn_out_norm": gain(ks[13], (DEPTH, HG_DIM)),
        "w_out": w(ks[14], (DEPTH, MIX_WIDTH, D_MODEL), MIX_WIDTH),
        "ffn2_pre_norm": gain(ks[15], (DEPTH, D_MODEL)),
        "ffn2_post_norm": gain(ks[16], (DEPTH, D_MODEL)),
        "ffn2_w_gate": w(ks[17], (DEPTH, D_MODEL, D_FF), D_MODEL),
        "ffn2_w_up": w(ks[18], (DEPTH, D_MODEL, D_FF), D_MODEL),
        "ffn2_w_down": w(ks[19], (DEPTH, D_FF, D_MODEL), D_FF),
    }


def reference(x, ffn1_pre_norm, ffn1_post_norm, ffn1_w_gate, ffn1_w_up, ffn1_w_down,
              mix_pre_norm, mix_post_norm, w_in, attn_sink, attn_out_norm,
              hgrn_lb_fwd, hgrn_lb_bwd, hgrn_out_norm, w_out,
              ffn2_pre_norm, ffn2_post_norm, ffn2_w_gate, ffn2_w_up, ffn2_w_down):
    for l in range(DEPTH):
        h = swiglu(rmsnorm(x, ffn1_pre_norm[l]), ffn1_w_gate[l], ffn1_w_up[l], ffn1_w_down[l])
        x = x + FFN_RES_WEIGHT * rmsnorm(h, ffn1_post_norm[l])
        h = hybrid_mixer(rmsnorm(x, mix_pre_norm[l]), w_in[l], attn_sink[l], attn_out_norm[l],
                         hgrn_lb_fwd, hgrn_lb_bwd, hgrn_out_norm[l], w_out[l], l)
        x = x + rmsnorm(h, mix_post_norm[l])
        h = swiglu(rmsnorm(x, ffn2_pre_norm[l]), ffn2_w_gate[l], ffn2_w_up[l], ffn2_w_down[l])
        x = x + FFN_RES_WEIGHT * rmsnorm(h, ffn2_post_norm[l])
    return x
```

```cpp
#include <hip/hip_runtime.h>
#include <hip/hip_cooperative_groups.h>
#include <cstdio>
#include <cstdint>
namespace cg = cooperative_groups;

constexpr int D_MODEL = 1024, BATCH = 16, SEQ = 4096, MTOK = BATCH * SEQ;
constexpr int D_FF = 2816, IN_WIDTH = 3328;
constexpr float EPS = 1e-6f;
constexpr float LOG2E = 1.4426950408889634f;
constexpr float QSCALE = 0.125f * LOG2E;

constexpr size_t MiB = 1u << 20;
constexpr size_t WS_ROPE = 1 * MiB;
constexpr size_t WS_W1GU = 2 * MiB, WS_W1D = 13 * MiB, WS_WIN = 19 * MiB, WS_WOUT = 26 * MiB, WS_W2GU = 28 * MiB, WS_W2D = 39 * MiB;
constexpr size_t WS_XN = 48 * MiB;
constexpr size_t WS_Y = 176 * MiB;
constexpr size_t WS_H = 304 * MiB;
constexpr size_t WS_QB = 304 * MiB, WS_KB = 368 * MiB, WS_VB = 384 * MiB, WS_HQ = 400 * MiB, WS_HV = 464 * MiB, WS_HG = 528 * MiB;
constexpr size_t WS_KT = 592 * MiB, WS_KK = 720 * MiB, WS_EB = 848 * MiB;
constexpr size_t WS_EBL = 976 * MiB;
constexpr size_t WS_XB = 980 * MiB;
constexpr size_t WS_SS2 = 984 * MiB;
constexpr size_t WS_END = 985 * MiB;
constexpr size_t CTL_BYTES = 262144;
constexpr int LDS_BYTES = 147456;

namespace pg8 {
#define PG8_LAS __attribute__((address_space(3)))
typedef unsigned short bf16_t;
typedef short bf16x8 __attribute__((ext_vector_type(8)));
typedef float f32x4 __attribute__((ext_vector_type(4)));
typedef unsigned u32x4 __attribute__((ext_vector_type(4)));
constexpr int BM = 256, BK = 64, HALF = 128, HTB = HALF * BK * 2  , STAGE_BYTES = 8 * HTB, NXCD = 8, WGM = 8;

__host__ __device__ __forceinline__ int lds_byte(int r, int c) { const int st = (r >> 4) * 2 + (c >> 5), rr = r & 15, cc = c & 31, ob = rr * 64 + cc * 2; return st * 1024 + (ob ^ (((ob >> 9) & 1) << 5)); }
__host__ __device__ __forceinline__ void stage_rc(int b, int& R, int& C) { const int st = b / 1024, sb = b % 1024, swz = sb ^ (((sb >> 9) & 1) << 5); R = (st >> 1) * 16 + swz / 64; C = (st & 1) * 32 + (swz % 64) / 2; }
__host__ __device__ __forceinline__ int perm32(int rho) { const int n = rho >> 4, i = rho & 15; return 8 * (i >> 2) + 4 * n + (i & 3); }

struct Unit { int pm, pn; };
struct Gemm { const bf16_t* A; const bf16_t* Bt; int M, N, K; };

struct StaticOrder {
    int nM, nN, nwg, G, c;
    __host__ __device__ void init(int M, int N, int G_, int c_) { nM = M / BM; nN = N / BM; nwg = nM * nN; G = G_; c = c_; }
    __host__ __device__ bool next(int i, Unit& u) const {
        const long L = (long)i * G + c; if (L >= nwg) return false;
        int wgid = (int)L; { const int q = nwg / NXCD, r = nwg % NXCD, xcd = wgid % NXCD, off = wgid / NXCD; wgid = (xcd < r ? xcd * (q + 1) : r * (q + 1) + (xcd - r) * q) + off; }
        const int nig = WGM * nN, gid = wgid / nig, fm = gid * WGM, gsz = (nM - fm) < WGM ? (nM - fm) : WGM;
        u.pm = fm + ((wgid % nig) % gsz); u.pn = (wgid % nig) / gsz; return true;
    }
    __device__ __forceinline__ void a_ready(const Unit&) const {}
    __device__ __forceinline__ void done(const Unit&) const {}
};
typedef unsigned u32x2 __attribute__((ext_vector_type(2)));
typedef float f32x2_t __attribute__((ext_vector_type(2))); typedef __bf16 bf16x2_t __attribute__((ext_vector_type(2)));
__device__ __forceinline__ unsigned cvt_pk_bf16(float lo, float hi) { f32x2_t v = {lo, hi}; bf16x2_t b = __builtin_convertvector(v, bf16x2_t); return __builtin_bit_cast(unsigned, b); }
__device__ __forceinline__ void store8(bf16_t* p, const f32x4 v0, const f32x4 v1) {
    u32x4 w; w.x = cvt_pk_bf16(v0[0], v0[1]); w.y = cvt_pk_bf16(v0[2], v0[3]); w.z = cvt_pk_bf16(v1[0], v1[1]); w.w = cvt_pk_bf16(v1[2], v1[3]); *(u32x4*)p = w; }
__device__ __forceinline__ void store4(bf16_t* p, const f32x4 v0) { u32x2 w; w.x = cvt_pk_bf16(v0[0], v0[1]); w.y = cvt_pk_bf16(v0[2], v0[3]); *(u32x2*)p = w; }
__device__ __forceinline__ float fsigmoid(float x) { return __builtin_amdgcn_rcpf(1.0f + __builtin_amdgcn_exp2f(-1.4426950408889634f * x)); }
__device__ __forceinline__ f32x4 sigmoid4(f32x4 v) { return (f32x4){fsigmoid(v[0]), fsigmoid(v[1]), fsigmoid(v[2]), fsigmoid(v[3])}; }

__device__ __forceinline__ float row_rs(const float* ss4, int row) { const f32x4 p = *(const f32x4*)(ss4 + (unsigned)(row * 4)); return __builtin_amdgcn_rsqf(((p[0] + p[1]) + (p[2] + p[3])) * (1.0f / 1024.0f) + 1e-6f); }
__device__ __forceinline__ const PG8_LAS float* row_scale_table(const float* ss4, int pm, PG8_LAS unsigned char* ldse, int wid, int lane) {
    PG8_LAS float* rst = (PG8_LAS float*)(ldse + 4096); volatile PG8_LAS int* tag = (volatile PG8_LAS int*)(ldse + 4096 + 1024);
    if (*tag != pm) {
        const int t_ = wid * 64 + lane; if (t_ < 256) rst[t_] = row_rs(ss4, pm * BM + t_);
        asm volatile("s_waitcnt lgkmcnt(0)" ::: "memory"); __builtin_amdgcn_s_barrier(); asm volatile("" ::: "memory");
        if (t_ == 0) *tag = pm;
    }
    return rst;
}
struct EpiPlain {
    static constexpr bool PERM = true, AFTER_DRAIN = false;
    bf16_t* O; int ldc;
    __device__ __forceinline__ void operator()(const f32x4 (&acc)[2][2][4][2], const Unit& u, int wr, int wc, int fr, int fq, PG8_LAS unsigned char*, int, int) const {
        const int row0 = u.pm * BM + wr * 64 + fr, col0 = u.pn * BM + wc * 32 + 8 * fq;
#pragma unroll
        for (int ai = 0; ai < 2; ++ai)
#pragma unroll
            for (int m = 0; m < 4; ++m) { bf16_t* rowp = O + (size_t)(row0 + ai * HALF + m * 16) * ldc + col0;
#pragma unroll
                for (int bj = 0; bj < 2; ++bj) store8(rowp + bj * HALF, acc[ai][bj][m][0], acc[ai][bj][m][1]); }
    }
};
struct EpiSwiGLU {
    static constexpr bool PERM = true, AFTER_DRAIN = false;
    bf16_t* H; int ldh; const float* ss2;
    __device__ __forceinline__ void operator()(const f32x4 (&acc)[2][2][4][2], const Unit& u, int wr, int wc, int fr, int fq, PG8_LAS unsigned char* ldse, int wid, int lane_) const {
        const int row0 = u.pm * BM + wr * 64 + fr, col0 = u.pn * HALF + wc * 32 + 8 * fq;
        const PG8_LAS float* rsl = row_scale_table(ss2, u.pm, ldse, wid, lane_) + wr * 64 + fr;
#pragma unroll
        for (int ai = 0; ai < 2; ++ai)
#pragma unroll
            for (int m = 0; m < 4; ++m) { bf16_t* rowp = H + (size_t)(row0 + ai * HALF + m * 16) * ldh + col0;
                const float rs = rsl[ai * HALF + m * 16];
                const f32x4 g0 = acc[ai][0][m][0] * rs, g1 = acc[ai][0][m][1] * rs, u0 = acc[ai][1][m][0] * rs, u1 = acc[ai][1][m][1] * rs;
                store8(rowp, g0 * sigmoid4(g0) * u0, g1 * sigmoid4(g1) * u1); }
    }
};
struct EpiMixer {
    static constexpr bool PERM = true, AFTER_DRAIN = false;
    unsigned char* ws; const float* ss2;
    const float *lbf, *lbb;
    __device__ __forceinline__ void operator()(const f32x4 (&acc)[2][2][4][2], const Unit& u, int wr, int wc, int fr, int fq, PG8_LAS unsigned char* ldse, int wid, int lane_) const {
        const int pn = u.pn; const int row0 = u.pm * BM + wr * 64 + fr; const int cl0 = wc * 32 + 8 * fq;
        const PG8_LAS float* rsl = row_scale_table(ss2, u.pm, ldse, wid, lane_) + wr * 64 + fr;
        bf16_t* const QB = (bf16_t*)(ws + WS_QB); bf16_t* const KB = (bf16_t*)(ws + WS_KB); bf16_t* const VB = (bf16_t*)(ws + WS_VB); bf16_t* const HQ = (bf16_t*)(ws + WS_HQ);
        bf16_t* const HV = (bf16_t*)(ws + WS_HV); bf16_t* const HG = (bf16_t*)(ws + WS_HG); const float* const rope = (const float*)(ws + WS_ROPE);
        if (pn <= 2) {
#ifndef NO_B1
            float rsa[2][4];
#pragma unroll
            for (int ai = 0; ai < 2; ++ai)
#pragma unroll
                for (int m = 0; m < 4; ++m) rsa[ai][m] = rsl[ai * HALF + m * 16];
            const bool rotw = (wc & 1) == 0;
#pragma unroll
            for (int ai = 0; ai < 2; ++ai)
#pragma unroll
                for (int m = 0; m < 4; ++m) { const int row = row0 + ai * HALF + m * 16; const int pos = row & (SEQ - 1); const float rsr = rsa[ai][m];
                    f32x4 c0 = {1.f, 1.f, 1.f, 1.f}, c1 = c0, s0 = {0.f, 0.f, 0.f, 0.f}, s1 = s0;
                    if (rotw && fq < 2) { const f32x4* rp = (const f32x4*)(rope + pos * 16); c0 = rp[0]; c1 = rp[1]; s0 = rp[2]; s1 = rp[3]; if (fq == 0) { s0 = -s0; s1 = -s1; } }
#pragma unroll
                    for (int bj = 0; bj < 2; ++bj) { f32x4 v0 = acc[ai][bj][m][0] * rsr, v1 = acc[ai][bj][m][1] * rsr;
                        const bool dorot = rotw && !(pn == 2 && bj == 1);
                        if (dorot) { f32x4 p0, p1;
#pragma unroll
                            for (int i = 0; i < 4; ++i) { p0[i] = __shfl_xor(v0[i], 16); p1[i] = __shfl_xor(v1[i], 16); }
                            v0 = v0 * c0 + p0 * s0; v1 = v1 * c1 + p1 * s1; }
                        if (pn < 2) { v0 = v0 * QSCALE; v1 = v1 * QSCALE; store8(QB + (size_t)row * 512 + pn * 256 + bj * HALF + cl0, v0, v1); }
                        else if (bj == 0) store8(KB + (size_t)row * 128 + cl0, v0, v1);
                        else store8(VB + (size_t)row * 128 + cl0, v0, v1); }
                    if (m & 1) asm volatile("" ::: "memory"); }
#endif
        } else if (pn <= 4 || pn >= 9) {
#ifndef NO_B2
        float rsa[2][4];
#pragma unroll
        for (int ai = 0; ai < 2; ++ai)
#pragma unroll
            for (int m = 0; m < 4; ++m) rsa[ai][m] = rsl[ai * HALF + m * 16];
            bf16_t* dst = pn <= 4 ? HQ : (pn <= 10 ? HV : HG); const int cb = (pn <= 4 ? pn - 3 : (pn <= 10 ? pn - 9 : pn - 11)) * 256 + cl0; const bool mulx = pn >= 9;
#pragma unroll
            for (int ai = 0; ai < 2; ++ai)
#pragma unroll
                for (int m = 0; m < 4; ++m) { const int row = row0 + ai * HALF + m * 16; const float rsr = rsa[ai][m];
#pragma unroll
                    for (int bj = 0; bj < 2; ++bj) { f32x4 v0 = acc[ai][bj][m][0] * rsr, v1 = acc[ai][bj][m][1] * rsr; f32x4 a0 = sigmoid4(v0), a1 = sigmoid4(v1);
                        if (mulx) { a0 = a0 * v0; a1 = a1 * v1; }
                        store8(dst + (size_t)row * 512 + cb + bj * HALF, a0, a1); }
                    asm volatile("" ::: "memory"); }
#endif
        } else {
#ifndef NO_B3
            const int dir = (pn - 5) >> 1; const int cb = ((pn - 5) & 1) * 256 + cl0; const float* lbr = dir ? lbb : lbf;
            const size_t dstride = (size_t)MTOK * 512; bf16_t* kt = (bf16_t*)(ws + WS_KT) + dir * dstride; bf16_t* eb = (bf16_t*)(ws + WS_EB) + dir * dstride; float* ebl = (float*)(ws + WS_EBL) + (size_t)dir * (MTOK / 64) * 512;
            const int lane = fq * 16 + fr;
#pragma unroll
            for (int ai = 0; ai < 2; ++ai)
#pragma unroll
                for (int bj = 0; bj < 2; ++bj) { const int colg = cb + bj * HALF;
                  u32x4 ebp[4], ktp[4]; f32x4 eTa, eTb;
                  float rsr[4];
#pragma unroll
                  for (int m = 0; m < 4; ++m) rsr[m] = rsl[ai * HALF + m * 16];
#pragma unroll
                  for (int nh = 0; nh < 4; ++nh) { const int n = nh >> 1, eh = (nh & 1) * 2; const int col = colg + 4 * n + eh;
                    float lb[2];
#pragma unroll
                    for (int e = 0; e < 2; ++e) lb[e] = ((const PG8_LAS float*)ldse)[dir * 512 + col + e];
                    float G[4][2], KC[4][2];
#pragma unroll
                    for (int m = 0; m < 4; ++m) {
#pragma unroll
                        for (int e = 0; e < 2; ++e) { float x = acc[ai][bj][m][n][eh + e] * rsr[m]; asm volatile("" : "+v"(x)); const float f = lb[e] + (1.0f - lb[e]) * fsigmoid(x); G[m][e] = __builtin_amdgcn_logf(f); KC[m][e] = 1.0f - f; } }
                    float T[2];
#pragma unroll
                    for (int e = 0; e < 2; ++e) { float tot = 0.f;
#pragma unroll
                        for (int m = 0; m < 4; ++m) { float v = G[m][e];
                            v += __builtin_bit_cast(float, __builtin_amdgcn_update_dpp(0, __builtin_bit_cast(int, v), 0x111, 0xf, 0xf, true));
                            v += __builtin_bit_cast(float, __builtin_amdgcn_update_dpp(0, __builtin_bit_cast(int, v), 0x112, 0xf, 0xf, true));
                            v += __builtin_bit_cast(float, __builtin_amdgcn_update_dpp(0, __builtin_bit_cast(int, v), 0x114, 0xf, 0xf, true));
                            v += __builtin_bit_cast(float, __builtin_amdgcn_update_dpp(0, __builtin_bit_cast(int, v), 0x118, 0xf, 0xf, true));
                            const float rt = __builtin_bit_cast(float, __builtin_amdgcn_ds_bpermute(((lane | 15) << 2), __builtin_bit_cast(int, v)));
                            const float P = v + tot; tot += rt;
                            G[m][e] = dir ? (G[m][e] - P) : P; }
                        T[e] = tot; }
                    const float eT0 = __builtin_amdgcn_exp2f(T[0]), eT1 = __builtin_amdgcn_exp2f(T[1]);
                    if (nh < 2) { eTa[2 * nh] = eT0; eTa[2 * nh + 1] = eT1; } else { eTb[2 * nh - 4] = eT0; eTb[2 * nh - 3] = eT1; }
#pragma unroll
                    for (int m = 0; m < 4; ++m) {
                        const float b0 = dir ? G[m][0] + T[0] : G[m][0], b1 = dir ? G[m][1] + T[1] : G[m][1];
                        const float eb0 = __builtin_amdgcn_exp2f(b0), eb1 = __builtin_amdgcn_exp2f(b1);
                        const float kt0 = KC[m][0] * __builtin_amdgcn_rcpf(eb0), kt1 = KC[m][1] * __builtin_amdgcn_rcpf(eb1);
                        ebp[m][nh] = cvt_pk_bf16(eb0, eb1); ktp[m][nh] = cvt_pk_bf16(kt0, kt1);
                        asm volatile("" : "+v"(ebp[m]), "+v"(ktp[m])); }
                  }
#pragma unroll
                  for (int m = 0; m < 4; ++m) { const unsigned off = (unsigned)((row0 + ai * HALF + m * 16) * 512 + colg); *(u32x4*)(eb + off) = ebp[m]; *(u32x4*)(kt + off) = ktp[m]; }
                  if (fr == 0) { const int rowc = row0 + ai * HALF; float* p = ebl + (unsigned)((rowc >> 6) * 512 + colg); *(f32x4*)p = eTa; *(f32x4*)(p + 4) = eTb; }
                  asm volatile("" ::: "memory");
                }
#endif
        }
    }
};


struct EpiNormRes2 {
    static constexpr bool PERM = true, AFTER_DRAIN = false;
    bf16_t* xb; float* outf; const float* wpost; float scale;
    float* xbuf; unsigned* cnt; float* ss2;
    __device__ __forceinline__ void operator()(const f32x4 (&acc)[2][2][4][2], const Unit& u, int wr, int wc, int fr, int fq, PG8_LAS unsigned char* lds, int wid, int lane) const {
        PG8_LAS float* Pt = (PG8_LAS float*)lds;
        PG8_LAS float* St = Pt + 1024;
        const int tid = wid * 64 + lane;
        const int col0 = u.pn * BM + wc * 32 + 8 * fq;
        unsigned off0 = (unsigned)((u.pm * BM + wr * 64 + fr) * 1024 + col0); asm volatile("" : "+v"(off0));
        u32x2 bs[2][4][2][2]; f32x4 wv[2][2];
#pragma unroll
        for (int bj = 0; bj < 2; ++bj) { wv[bj][0] = *(const f32x4*)(wpost + col0 + bj * HALF); wv[bj][1] = *(const f32x4*)(wpost + col0 + bj * HALF + 4);
#pragma unroll
            for (int ai = 0; ai < 2; ++ai)
#pragma unroll
                for (int m = 0; m < 4; ++m) { const bf16_t* p_ = xb + off0 + (unsigned)((ai * HALF + m * 16) * 1024 + bj * HALF); bs[ai][m][bj][0] = *(const u32x2*)p_; bs[ai][m][bj][1] = *(const u32x2*)(p_ + 4); } }
#pragma unroll
        for (int ai = 0; ai < 2; ++ai)
#pragma unroll
            for (int m = 0; m < 4; ++m) { float s = 0.f;
#pragma unroll
                for (int bj = 0; bj < 2; ++bj)
#pragma unroll
                    for (int n = 0; n < 2; ++n) { const f32x4 x = acc[ai][bj][m][n]; s += (x[0] * x[0] + x[1] * x[1]) + (x[2] * x[2] + x[3] * x[3]); }
                s += __shfl_xor(s, 16); s += __shfl_xor(s, 32);
                if (fq == 0) Pt[(ai * HALF + wr * 64 + m * 16 + fr) * 4 + wc] = s; }
        asm volatile("s_waitcnt lgkmcnt(0)" ::: "memory"); __builtin_amdgcn_s_barrier(); asm volatile("" ::: "memory");
        if (tid < 256) { const f32x4 p = *(const PG8_LAS f32x4*)(Pt + tid * 4); const float tot = (p[0] + p[1]) + (p[2] + p[3]);
            float* sl = xbuf + (size_t)(u.pm * BM + tid) * 4;
            __hip_atomic_store(sl + u.pn, tot, __ATOMIC_RELAXED, __HIP_MEMORY_SCOPE_AGENT);
            float t0, t1, t2, t3; unsigned sp = 0;
            for (;;) {
                t0 = __hip_atomic_load(sl + 0, __ATOMIC_RELAXED, __HIP_MEMORY_SCOPE_AGENT); t1 = __hip_atomic_load(sl + 1, __ATOMIC_RELAXED, __HIP_MEMORY_SCOPE_AGENT);
                t2 = __hip_atomic_load(sl + 2, __ATOMIC_RELAXED, __HIP_MEMORY_SCOPE_AGENT); t3 = __hip_atomic_load(sl + 3, __ATOMIC_RELAXED, __HIP_MEMORY_SCOPE_AGENT);
                const int bad = (__builtin_bit_cast(int, t0) | __builtin_bit_cast(int, t1) | __builtin_bit_cast(int, t2) | __builtin_bit_cast(int, t3)) < 0;
                if (!__any(bad)) break;
                if (++sp > (1u << 16)) break;
                __builtin_amdgcn_s_sleep(1);
            }
            St[tid] = scale * __builtin_amdgcn_rsqf(((t0 + t1) + (t2 + t3)) * (1.0f / 1024.0f) + 1e-6f); }
        asm volatile("s_waitcnt vmcnt(0) lgkmcnt(0)" ::: "memory"); __builtin_amdgcn_s_barrier(); asm volatile("" ::: "memory");
        float q[2][4];
#pragma unroll
        for (int ai = 0; ai < 2; ++ai)
#pragma unroll
            for (int m = 0; m < 4; ++m) { const float r = St[ai * HALF + wr * 64 + m * 16 + fr]; float qq = 0.f;
#pragma unroll
                for (int bj = 0; bj < 2; ++bj) { const unsigned off = off0 + (unsigned)((ai * HALF + m * 16) * 1024 + bj * HALF); const u32x4 bw = {bs[ai][m][bj][0].x, bs[ai][m][bj][0].y, bs[ai][m][bj][1].x, bs[ai][m][bj][1].y};
                    const f32x4 b0 = {__builtin_bit_cast(float, bw.x << 16), __builtin_bit_cast(float, bw.x & 0xffff0000u), __builtin_bit_cast(float, bw.y << 16), __builtin_bit_cast(float, bw.y & 0xffff0000u)};
                    const f32x4 b1 = {__builtin_bit_cast(float, bw.z << 16), __builtin_bit_cast(float, bw.z & 0xffff0000u), __builtin_bit_cast(float, bw.w << 16), __builtin_bit_cast(float, bw.w & 0xffff0000u)};
                    const f32x4 x0 = b0 + acc[ai][bj][m][0] * wv[bj][0] * r, x1 = b1 + acc[ai][bj][m][1] * wv[bj][1] * r;
                    if (outf) { *(f32x4*)(outf + off) = x0; *(f32x4*)(outf + off + 4) = x1; }
                    else { u32x4 w; w.x = cvt_pk_bf16(x0[0], x0[1]); w.y = cvt_pk_bf16(x0[2], x0[3]); w.z = cvt_pk_bf16(x1[0], x1[1]); w.w = cvt_pk_bf16(x1[2], x1[3]); *(u32x4*)(xb + off) = w;
#pragma unroll
                        for (int k = 0; k < 4; ++k) { const float a = __builtin_bit_cast(float, w[k] << 16), b2 = __builtin_bit_cast(float, w[k] & 0xffff0000u); qq += a * a + b2 * b2; } } }
                q[ai][m] = qq; }
        if (!outf) {
#pragma unroll
            for (int ai = 0; ai < 2; ++ai)
#pragma unroll
                for (int m = 0; m < 4; ++m) { float s = q[ai][m]; s += __shfl_xor(s, 16); s += __shfl_xor(s, 32); if (fq == 0) Pt[(ai * HALF + wr * 64 + m * 16 + fr) * 4 + wc] = s; }
        }
        asm volatile("s_waitcnt lgkmcnt(0)" ::: "memory"); __builtin_amdgcn_s_barrier(); asm volatile("" ::: "memory");
        if (!outf && tid < 256) { const f32x4 p = *(const PG8_LAS f32x4*)(Pt + tid * 4); ss2[(unsigned)((u.pm * BM + tid) * 4 + u.pn)] = (p[0] + p[1]) + (p[2] + p[3]); }
    }
};
template <class Epi, class Sched, bool ALIGN_EPI = false, bool SP2 = false>
__device__ __forceinline__ void gemm_phase(PG8_LAS unsigned char* lds, const Gemm g, const Sched& S, const Epi& E) {
    int tid_ = threadIdx.x; asm volatile("" : "+v"(tid_));
    const int tid = tid_, wid = __builtin_amdgcn_readfirstlane(tid >> 6), lane = tid & 63, wr = wid >> 2, wc = wid & 3, fr = lane & 15, fq = lane >> 4;
    const int K = g.K, nt = K / BK;
    unsigned voffA[2], voffB[2];
#pragma unroll
    for (int i = 0; i < 2; ++i) { int R, C; stage_rc(tid * 16 + i * 8192, R, C); const int Rb = Epi::PERM ? ((R & ~31) + perm32(R & 31)) : R;
        voffA[i] = (unsigned)(R * K + C) * 2u; voffB[i] = (unsigned)(Rb * K + C) * 2u; }
    const size_t kstep = (size_t)(BK * 2);
    const size_t hstep = (size_t)HALF * K * 2;
    const size_t tstep = 2 * hstep;
    const unsigned ldsw = (unsigned)wid * 1024u;
    const int aoff = lds_byte(wr * 64 + fr, fq * 8), boff = lds_byte(wc * 32 + fr, fq * 8);
#define PG8_SA(b, h) (((b) * 2 + (h)) * HTB)
#define PG8_SB(b, h) ((4 + (b) * 2 + (h)) * HTB)
#define PG8_STAGE(bufoff, gbase, voff) do { _Pragma("unroll") for (int _i = 0; _i < 2; ++_i) \
        __builtin_amdgcn_global_load_lds((const unsigned*)((const char*)(gbase) + (voff)[_i]), (PG8_LAS unsigned*)(lds + (bufoff) + ldsw + _i * 8192), 16, 0, 0); } while (0)
#define PG8_LDA(dst, b, h) do { _Pragma("unroll") for (int m = 0; m < 4; ++m) _Pragma("unroll") for (int k = 0; k < 2; ++k) dst[m][k] = *(const PG8_LAS bf16x8*)(lds + PG8_SA(b, h) + aoff + m * 2048 + k * 1024); } while (0)
#define PG8_LDB(dst, b, h) do { _Pragma("unroll") for (int n = 0; n < 2; ++n) _Pragma("unroll") for (int k = 0; k < 2; ++k) dst[n][k] = *(const PG8_LAS bf16x8*)(lds + PG8_SB(b, h) + boff + n * 2048 + k * 1024); } while (0)
#define PG8_MMA(ai, bj, At, Bt) do { __builtin_amdgcn_s_setprio(1); _Pragma("unroll") for (int m = 0; m < 4; ++m) _Pragma("unroll") for (int n = 0; n < 2; ++n) _Pragma("unroll") for (int k = 0; k < 2; ++k) \
        acc[ai][bj][m][n] = __builtin_amdgcn_mfma_f32_16x16x32_bf16(Bt[n][k], At[m][k], acc[ai][bj][m][n], 0, 0, 0); __builtin_amdgcn_s_setprio(0); } while (0)
#define PG8_WAIT_V(n) asm volatile("s_waitcnt vmcnt(" #n ")" ::: "memory")
#define PG8_WAIT_L(n) asm volatile("s_waitcnt lgkmcnt(" #n ")" ::: "memory")
#define PG8_BAR __builtin_amdgcn_s_barrier()
#define PG8_SCHED __builtin_amdgcn_sched_barrier(0)
    Unit cur, nxt; int ui = 0;
    if (!S.next(0, cur)) return;
    f32x4 acc[2][2][4][2];
#pragma unroll
    for (int a = 0; a < 2; ++a)
#pragma unroll
        for (int b = 0; b < 2; ++b)
#pragma unroll
            for (int m = 0; m < 4; ++m)
#pragma unroll
                for (int n = 0; n < 2; ++n) acc[a][b][m][n] = (f32x4){0.f, 0.f, 0.f, 0.f};
    bf16x8 At[4][2], B0[2][2], B1[2][2];
    const char* cA = (const char*)g.A + (size_t)cur.pm * tstep; const char* cB = (const char*)g.Bt + (size_t)cur.pn * tstep;
    S.a_ready(cur);
    if constexpr (SP2) {
        PG8_STAGE(PG8_SB(0, 0), cB, voffB); PG8_STAGE(PG8_SB(0, 1), cB + hstep, voffB); PG8_STAGE(PG8_SA(0, 0), cA, voffA); PG8_STAGE(PG8_SA(0, 1), cA + hstep, voffA);
        if (wr == 1) PG8_BAR;
        PG8_WAIT_V(2); PG8_BAR;
        PG8_STAGE(PG8_SB(1, 0), cB + kstep, voffB); PG8_STAGE(PG8_SA(1, 0), cA + kstep, voffA); PG8_STAGE(PG8_SB(1, 1), cB + hstep + kstep, voffB);
        PG8_WAIT_V(6); PG8_BAR;
    } else {
        PG8_STAGE(PG8_SB(0, 0), cB, voffB); PG8_STAGE(PG8_SA(0, 0), cA, voffA); PG8_STAGE(PG8_SB(0, 1), cB + hstep, voffB); PG8_STAGE(PG8_SA(0, 1), cA + hstep, voffA);
        if (wr == 1) PG8_BAR;
        PG8_WAIT_V(4); PG8_BAR;
        PG8_STAGE(PG8_SB(1, 0), cB + kstep, voffB); PG8_STAGE(PG8_SA(1, 0), cA + kstep, voffA); PG8_STAGE(PG8_SB(1, 1), cB + hstep + kstep, voffB);
        PG8_WAIT_V(6); PG8_BAR;
    }
    for (;;) {
        const bool has_next = S.next(ui + 1, nxt);
        const char* nA = has_next ? (const char*)g.A + (size_t)nxt.pm * tstep : cA; const char* nB = has_next ? (const char*)g.Bt + (size_t)nxt.pn * tstep : cB;
        for (int t = 0; t < nt; t += 2) {
            const bool last = (t == nt - 2);
            const char* a1 = cA + (size_t)(t + 1) * kstep;
            const char* a2 = last ? nA : cA + (size_t)(t + 2) * kstep; const char* b2 = last ? nB : cB + (size_t)(t + 2) * kstep;
            const char* a3 = a2 + kstep; const char* b3 = b2 + kstep;
            if (last && has_next) S.a_ready(nxt);
            if constexpr (SP2) {
            PG8_LDB(B0, 0, 0); PG8_LDB(B1, 0, 1); PG8_SCHED; PG8_LDA(At, 0, 0); PG8_STAGE(PG8_SA(1, 1), a1 + hstep, voffA);
            PG8_WAIT_V(8); PG8_WAIT_L(0); PG8_BAR; PG8_MMA(0, 0, At, B0); PG8_MMA(0, 1, At, B1); PG8_BAR; PG8_SCHED;
            PG8_LDA(At, 0, 1); PG8_STAGE(PG8_SB(0, 0), b2, voffB); PG8_STAGE(PG8_SB(0, 1), b2 + hstep, voffB); PG8_STAGE(PG8_SA(0, 0), a2, voffA);
            PG8_WAIT_V(8); PG8_WAIT_L(0); PG8_BAR; PG8_MMA(1, 0, At, B0); PG8_MMA(1, 1, At, B1); PG8_BAR; PG8_SCHED;
            PG8_LDB(B0, 1, 0); PG8_LDB(B1, 1, 1); PG8_SCHED; PG8_LDA(At, 1, 0); PG8_STAGE(PG8_SA(0, 1), a2 + hstep, voffA);
            PG8_WAIT_V(8); PG8_WAIT_L(0); PG8_BAR; PG8_MMA(0, 0, At, B0); PG8_MMA(0, 1, At, B1); PG8_BAR; PG8_SCHED;
            PG8_LDA(At, 1, 1); PG8_STAGE(PG8_SB(1, 0), b3, voffB); PG8_STAGE(PG8_SB(1, 1), b3 + hstep, voffB); PG8_STAGE(PG8_SA(1, 0), a3, voffA);
            PG8_WAIT_V(8); PG8_WAIT_L(0); PG8_BAR; PG8_MMA(1, 0, At, B0); PG8_MMA(1, 1, At, B1); PG8_BAR; PG8_SCHED;
            } else {
            PG8_LDB(B0, 0, 0); PG8_SCHED; PG8_LDA(At, 0, 0); PG8_STAGE(PG8_SA(1, 1), a1 + hstep, voffA);
            PG8_WAIT_L(8); PG8_BAR; PG8_WAIT_L(0); PG8_MMA(0, 0, At, B0); PG8_BAR; PG8_SCHED;
            PG8_LDB(B1, 0, 1); PG8_STAGE(PG8_SB(0, 0), b2, voffB);
            PG8_BAR; PG8_WAIT_L(0); PG8_MMA(0, 1, At, B1); PG8_BAR;
            PG8_LDA(At, 0, 1); PG8_STAGE(PG8_SA(0, 0), a2, voffA);
            PG8_BAR; PG8_WAIT_L(0); PG8_MMA(1, 0, At, B0); PG8_BAR; PG8_SCHED;
            PG8_STAGE(PG8_SB(0, 1), b2 + hstep, voffB);
            PG8_WAIT_V(6); PG8_BAR; PG8_MMA(1, 1, At, B1); PG8_BAR;
            PG8_LDB(B0, 1, 0); PG8_SCHED; PG8_LDA(At, 1, 0); PG8_STAGE(PG8_SA(0, 1), a2 + hstep, voffA);
            PG8_WAIT_L(8); PG8_BAR; PG8_WAIT_L(0); PG8_MMA(0, 0, At, B0); PG8_BAR; PG8_SCHED;
            PG8_LDB(B1, 1, 1); PG8_STAGE(PG8_SB(1, 0), b3, voffB);
            PG8_BAR; PG8_WAIT_L(0); PG8_MMA(0, 1, At, B1); PG8_BAR;
            PG8_LDA(At, 1, 1); PG8_STAGE(PG8_SA(1, 0), a3, voffA);
            PG8_BAR; PG8_WAIT_L(0); PG8_MMA(1, 0, At, B0); PG8_BAR; PG8_SCHED;
            PG8_STAGE(PG8_SB(1, 1), b3 + hstep, voffB);
            PG8_WAIT_V(6); PG8_BAR; PG8_MMA(1, 1, At, B1); PG8_BAR;
            }
        }
        if constexpr (ALIGN_EPI) { if (wr == 0) PG8_BAR; }
        if constexpr (!Epi::AFTER_DRAIN) { E(acc, cur, wr, wc, fr, fq, lds + STAGE_BYTES, wid, lane); S.done(cur); }
        if (!has_next) break;
#pragma unroll
        for (int a = 0; a < 2; ++a)
#pragma unroll
            for (int b = 0; b < 2; ++b)
#pragma unroll
                for (int m = 0; m < 4; ++m)
#pragma unroll
                    for (int n = 0; n < 2; ++n) acc[a][b][m][n] = (f32x4){0.f, 0.f, 0.f, 0.f};
        cur = nxt; cA = nA; cB = nB; ++ui;
        if constexpr (ALIGN_EPI) { if (wr == 1) PG8_BAR; }
    }
    PG8_WAIT_V(0);
    if constexpr (!ALIGN_EPI) { if (wr == 0) PG8_BAR; }
    PG8_BAR;
    if constexpr (Epi::AFTER_DRAIN) { E.fused(acc, cur, wr, wc, fr, fq, lds, wid, lane); S.done(cur); }
#undef PG8_SA
#undef PG8_SB
#undef PG8_STAGE
#undef PG8_LDA
#undef PG8_LDB
#undef PG8_MMA
#undef PG8_WAIT_V
#undef PG8_WAIT_L
#undef PG8_BAR
#undef PG8_SCHED
}
}
#define LAS __attribute__((address_space(3)))
typedef unsigned short bf16;
typedef unsigned v4u __attribute__((ext_vector_type(4)));
typedef unsigned v2u __attribute__((ext_vector_type(2)));
typedef float f32x4 __attribute__((ext_vector_type(4)));
typedef short bf16x8 __attribute__((ext_vector_type(8)));
typedef short s16x4 __attribute__((ext_vector_type(4)));
constexpr int NWAVES = 8, NTHR = 512;

#define XB_TMO      128
#define XB_XCNT(j)  (256  + 64 * (j))
#define XB_XSUB(j)  (1280 + 64 * (j))
#define XB_XGEN(j)  (2304 + 64 * (j))
#define XB_TOP      3328
#define XB_TOPGEN   3392
#define XCD_BAR_WORDS 3456
#define XB_SPIN_CAP (1u << 18)

__device__ __forceinline__ unsigned xb_ld(unsigned* p)              { return __hip_atomic_load(p, __ATOMIC_RELAXED, __HIP_MEMORY_SCOPE_AGENT); }
__device__ __forceinline__ unsigned xb_add(unsigned* p, unsigned v) { return __hip_atomic_fetch_add(p, v, __ATOMIC_RELAXED, __HIP_MEMORY_SCOPE_AGENT); }
__device__ __forceinline__ unsigned xb_xcc_id() { return (unsigned)__builtin_amdgcn_s_getreg((3 << 11) | 20) & 0xFu; }
#define XB_SPIN(cond, bar) do { unsigned _sp = 0; while (cond) { __builtin_amdgcn_s_sleep(1); \
    if ((++_sp & 255u) == 0u) { if (xb_ld(&(bar)[XB_TMO])) break; if (_sp > XB_SPIN_CAP) { atomicAdd(&(bar)[XB_TMO], 1u); break; } } } } while (0)

struct XcdBarrier {
    unsigned* bar; unsigned x;
    volatile LAS unsigned* st;
};

__device__ __forceinline__ XcdBarrier xcd_barrier_post(unsigned* bar, volatile LAS unsigned* st) {
    XcdBarrier b; b.bar = bar; b.x = xb_xcc_id(); b.st = st;
    if (threadIdx.x == 0) (void)xb_add(&bar[XB_XCNT(b.x)], 1u);
    return b;
}
__device__ __forceinline__ void xcd_barrier_complete(unsigned* bar, unsigned x, unsigned& nloc, unsigned& nx) {
    const unsigned G = gridDim.x * gridDim.y * gridDim.z;
    unsigned sum, cnt, mine, sp = 0u;
    for (;;) {
        sum = 0u; cnt = 0u; mine = 0u;
#pragma unroll
        for (unsigned j = 0; j < 16; ++j) { const unsigned c = xb_ld(&bar[XB_XCNT(j)]); sum += c; cnt += (c > 0u) ? 1u : 0u; mine = (j == x) ? c : mine; }
        if (sum == G) break;
        __builtin_amdgcn_s_sleep(1);
        if ((++sp & 255u) == 0u) { if (xb_ld(&bar[XB_TMO])) break; if (sp > XB_SPIN_CAP) { atomicAdd(&bar[XB_TMO], 1u); break; } }
    }
    nloc = mine > 0u ? mine : 1u; nx = cnt > 0u ? cnt : 1u;
}

__device__ __forceinline__ void xcd_barrier(const XcdBarrier& b) {
    asm volatile("s_waitcnt vmcnt(0)" ::: "memory");
    __syncthreads();
    if (threadIdx.x == 0) {
        unsigned* bar = b.bar;
        __builtin_amdgcn_s_waitcnt(0);
        unsigned nloc = b.st[0], nx = b.st[1];
        if (nloc == 0u) { xcd_barrier_complete(bar, b.x, nloc, nx); b.st[0] = nloc; b.st[1] = nx; }
        const unsigned old = xb_add(&bar[XB_XSUB(b.x)], 1u);
        const unsigned gen = old / nloc;
        if (old + 1u == (gen + 1u) * nloc) {
            __builtin_amdgcn_fence(__ATOMIC_RELEASE, "agent");
            asm volatile("s_waitcnt vmcnt(0)" ::: "memory");
            const unsigned og = xb_add(&bar[XB_TOP], 1u);
            const unsigned tg = og / nx;
            if (og + 1u == (tg + 1u) * nx) xb_add(&bar[XB_TOPGEN], 1u);
            else XB_SPIN(xb_ld(&bar[XB_TOPGEN]) == tg, bar);
            __builtin_amdgcn_fence(__ATOMIC_ACQUIRE, "agent");
            xb_add(&bar[XB_XGEN(b.x)], 1u);
            asm volatile("s_waitcnt vmcnt(0)" ::: "memory");
        } else {
            XB_SPIN(xb_ld(&bar[XB_XGEN(b.x)]) == gen, bar);
            __builtin_amdgcn_fence(__ATOMIC_ACQUIRE, "agent");
            asm volatile("s_waitcnt vmcnt(0)" ::: "memory");
        }
    }
    __syncthreads();
}

__device__ __forceinline__ unsigned pk2(float lo, float hi) { return pg8::cvt_pk_bf16(lo, hi); }
__device__ __forceinline__ float bf_lo(unsigned w) { return __builtin_bit_cast(float, w << 16); }
__device__ __forceinline__ float bf_hi(unsigned w) { return __builtin_bit_cast(float, w & 0xffff0000u); }
__device__ __forceinline__ float wave_sum(float v) {
#pragma unroll
    for (int o = 1; o < 64; o <<= 1) v += __shfl_xor(v, o);
    return v;
}
__device__ __forceinline__ float row16_sum(float v) {
    v += __builtin_bit_cast(float, __builtin_amdgcn_update_dpp(0, __builtin_bit_cast(int, v), 0x128, 0xf, 0xf, false));
    v += __builtin_bit_cast(float, __builtin_amdgcn_update_dpp(0, __builtin_bit_cast(int, v), 0x124, 0xf, 0xf, false));
    v += __builtin_bit_cast(float, __builtin_amdgcn_update_dpp(0, __builtin_bit_cast(int, v), 0x122, 0xf, 0xf, false));
    v += __builtin_bit_cast(float, __builtin_amdgcn_update_dpp(0, __builtin_bit_cast(int, v), 0x121, 0xf, 0xf, false));
    return v;
}
struct Params {
    const float* in[20]; float* out; unsigned char* ws;
};

__device__ __forceinline__ void transpose_item(const float* W, int K, int N, bf16* WT, int mode, LAS float* scr, int item, int lane, const float* kscale = nullptr) {
    const int nblk = N / 32, kb = item / nblk, nb = item % nblk, k0 = 64 * kb, n0 = 32 * nb;
    const int r0 = mode == 0 ? n0 : ((n0 >> 7) * 256 + (n0 & 127) + (mode == 2 ? 128 : 0));
#pragma unroll 8
    for (int i = 0; i < 32; ++i) { const int kk = 2 * i + (lane >> 5); float wv = W[(size_t)(k0 + kk) * N + n0 + (lane & 31)]; if (kscale) wv *= kscale[k0 + kk]; scr[kk * 33 + (lane & 31)] = wv; }
    asm volatile("s_waitcnt lgkmcnt(0)" ::: "memory");
    const int c = lane & 7;
#pragma unroll
    for (int j = 0; j < 4; ++j) { const int n = (lane >> 3) + 8 * j; const LAS float* s = scr + (8 * c) * 33 + n;
        v4u o; o.x = pk2(s[0 * 33], s[1 * 33]); o.y = pk2(s[2 * 33], s[3 * 33]); o.z = pk2(s[4 * 33], s[5 * 33]); o.w = pk2(s[6 * 33], s[7 * 33]);
        *(v4u*)(WT + (size_t)(r0 + n) * K + k0 + 8 * c) = o; }
    asm volatile("s_waitcnt lgkmcnt(0)" ::: "memory");
}

template <int MODE>
__device__ __forceinline__ void row_pass2(const float* xin, bf16* XB, const bf16* Y, const float* wpost, float scale, float* xout, float* R2, int gw, int NGW, int lane, int mbeg = 0, int mend = MTOK) {
    constexpr int RB = 2;
    struct Stage { f32x4 v[RB][4]; v2u xw[RB][4]; v2u yw[RB][4]; };
    Stage st[2];
#define RP_LOAD(S_, m0_) do { _Pragma("unroll") for (int r = 0; r < RB; ++r) { \
            if (MODE <= 1) { const f32x4* xr = (const f32x4*)(xin + (size_t)((m0_) + r) * D_MODEL) + lane; _Pragma("unroll") for (int j = 0; j < 4; ++j) S_.v[r][j] = xr[64 * j]; } \
            else { const v2u* xr = (const v2u*)(XB + (size_t)((m0_) + r) * D_MODEL) + lane; _Pragma("unroll") for (int j = 0; j < 4; ++j) S_.xw[r][j] = xr[64 * j]; } \
            if (MODE >= 1) { const v2u* yr = (const v2u*)(Y + (size_t)((m0_) + r) * D_MODEL) + lane; _Pragma("unroll") for (int j = 0; j < 4; ++j) S_.yw[r][j] = yr[64 * j]; } } } while (0)
#define RP_COMPUTE(S_, m0_) do { _Pragma("unroll") for (int r = 0; r < RB; ++r) { const int m = (m0_) + r; f32x4 v[4]; \
            _Pragma("unroll") for (int j = 0; j < 4; ++j) { if (MODE <= 1) v[j] = S_.v[r][j]; else { const v2u w = S_.xw[r][j]; v[j] = (f32x4){bf_lo(w.x), bf_hi(w.x), bf_lo(w.y), bf_hi(w.y)}; } } \
            if (MODE >= 1) { f32x4 y[4]; float ss = 0.f; \
                _Pragma("unroll") for (int j = 0; j < 4; ++j) { const v2u w = S_.yw[r][j]; y[j] = (f32x4){bf_lo(w.x), bf_hi(w.x), bf_lo(w.y), bf_hi(w.y)}; ss += (y[j].x * y[j].x + y[j].y * y[j].y) + (y[j].z * y[j].z + y[j].w * y[j].w); } \
                const float rr = scale * __builtin_amdgcn_rsqf(wave_sum(ss) * (1.f / D_MODEL) + EPS); \
                _Pragma("unroll") for (int j = 0; j < 4; ++j) { const f32x4 w = ((const f32x4*)wpost)[lane + 64 * j]; v[j] = v[j] + y[j] * w * rr; } } \
            if (MODE == 3) { f32x4* xo = (f32x4*)(xout + (size_t)m * D_MODEL) + lane; _Pragma("unroll") for (int j = 0; j < 4; ++j) __builtin_nontemporal_store(v[j], xo + 64 * j); } \
            else { float ss = 0.f; v2u* o = (v2u*)(XB + (size_t)m * D_MODEL) + lane; \
                _Pragma("unroll") for (int j = 0; j < 4; ++j) { const v2u w = (v2u){pk2(v[j].x, v[j].y), pk2(v[j].z, v[j].w)}; o[64 * j] = w; \
                    const float a = bf_lo(w.x), b2 = bf_hi(w.x), c = bf_lo(w.y), d = bf_hi(w.y); ss += (a * a + b2 * b2) + (c * c + d * d); } \
                ss = wave_sum(ss); if (lane == 0) *(f32x4*)(R2 + (size_t)m * 4) = (f32x4){ss, 0.f, 0.f, 0.f}; } } } while (0)
    const int stride = NGW * RB;
    int m0 = mbeg + gw * RB;
    if (m0 < mend) RP_LOAD(st[0], m0);
    for (; m0 < mend; m0 += 2 * stride) {
        if (m0 + stride < mend) RP_LOAD(st[1], m0 + stride);
        RP_COMPUTE(st[0], m0);
        if (m0 + stride < mend) { if (m0 + 2 * stride < mend) RP_LOAD(st[0], m0 + 2 * stride); RP_COMPUTE(st[1], m0 + stride); }
    }
#undef RP_LOAD
#undef RP_COMPUTE
}

__device__ __forceinline__ s16x4 tr_read(const LAS bf16* p) { typedef short v4i16_t __attribute__((ext_vector_type(4))); return __builtin_bit_cast(s16x4, __builtin_amdgcn_ds_read_tr16_b64_v4i16((LAS v4i16_t*)p)); }
__device__ __forceinline__ bf16x8 cat4(s16x4 a, s16x4 b) { return (bf16x8){a[0], a[1], a[2], a[3], b[0], b[1], b[2], b[3]}; }
#define MFMA16(a, b, c) __builtin_amdgcn_mfma_f32_16x16x32_bf16((a), (b), (c), 0, 0, 0)

constexpr int SQ = 136, SV = 72;
struct ScanStage { v4u rq[2], re[2], rkt[2], rv; float rebl; };
__device__ __forceinline__ void scan_phase(LAS unsigned char* lds, unsigned char* ws, int nblk, int bid, int tid) {
    asm volatile("" : "+v"(tid));
    LAS bf16* QT = (LAS bf16*)lds;
    LAS bf16* KTs = QT + 64 * SQ;
    LAS bf16* Vs = KTs + 64 * SQ;
    LAS bf16* Ps = Vs + 64 * SV;
    LAS bf16* Ss = Ps + 64 * SV;
    LAS float* EBLs = (LAS float*)(Ss + 128 * SV);
    const int lane = tid & 63, w = __builtin_amdgcn_readfirstlane(tid >> 6), g = lane >> 4, l15 = lane & 15, q4 = l15 >> 2, p4 = lane & 3;
    const bf16* HQ = (const bf16*)(ws + WS_HQ); const bf16* HV = (const bf16*)(ws + WS_HV);
    for (int item = bid; item < 256; item += nblk) {
        const int vh = item & 1, dir = (item >> 1) & 1, h = (item >> 2) & 3, b = item >> 4;
        const bf16* KT = (const bf16*)(ws + WS_KT) + (size_t)dir * MTOK * 512;
        const bf16* EB = (const bf16*)(ws + WS_EB) + (size_t)dir * MTOK * 512; const float* EBL = (const float*)(ws + WS_EBL) + (size_t)dir * (MTOK / 64) * 512;
        bf16* OD = (bf16*)(ws + WS_Y) + (size_t)dir * MTOK * 512;
        f32x4 sacc[4];
#pragma unroll
        for (int c = 0; c < 4; ++c) sacc[c] = (f32x4){0.f, 0.f, 0.f, 0.f};
        const int prow0 = tid >> 4, pc8 = tid & 15, vrow = tid >> 3, vc8 = tid & 7;
        ScanStage st[2];
#define SCAN_ISSUE(S_, stp) do { const int c_ = dir ? 63 - (stp) : (stp); const size_t rb_ = (size_t)b * SEQ + (size_t)c_ * 64; \
            _Pragma("unroll") for (int i = 0; i < 2; ++i) { const size_t off_ = (rb_ + prow0 + 32 * i) * 512 + h * 128 + 8 * pc8; \
                S_.rq[i] = *(const v4u*)(HQ + off_); S_.re[i] = *(const v4u*)(EB + off_); S_.rkt[i] = *(const v4u*)(KT + off_); } \
            S_.rv = *(const v4u*)(HV + (rb_ + vrow) * 512 + h * 128 + vh * 64 + 8 * vc8); \
            S_.rebl = (tid < 128) ? EBL[((size_t)b * 64 + c_) * 512 + h * 128 + tid] : 0.f; } while (0)
        SCAN_ISSUE(st[0], 0); SCAN_ISSUE(st[1], 1);
        __syncthreads();
#define SCAN_STEP(S_, step) do { \
            const int c = dir ? 63 - (step) : (step); \
              \
            _Pragma("unroll") for (int i = 0; i < 2; ++i) { const int row = prow0 + 32 * i; v4u qt; \
                qt.x = pk2(bf_lo(S_.rq[i].x) * bf_lo(S_.re[i].x), bf_hi(S_.rq[i].x) * bf_hi(S_.re[i].x)); qt.y = pk2(bf_lo(S_.rq[i].y) * bf_lo(S_.re[i].y), bf_hi(S_.rq[i].y) * bf_hi(S_.re[i].y)); \
                qt.z = pk2(bf_lo(S_.rq[i].z) * bf_lo(S_.re[i].z), bf_hi(S_.rq[i].z) * bf_hi(S_.re[i].z)); qt.w = pk2(bf_lo(S_.rq[i].w) * bf_lo(S_.re[i].w), bf_hi(S_.rq[i].w) * bf_hi(S_.re[i].w)); \
                *(LAS v4u*)(QT + row * SQ + 8 * pc8) = qt; *(LAS v4u*)(KTs + row * SQ + 8 * pc8) = S_.rkt[i]; } \
            *(LAS v4u*)(Vs + vrow * SV + 8 * vc8) = S_.rv; \
            if (tid < 128) EBLs[tid] = S_.rebl; \
            _Pragma("unroll") for (int cc = 0; cc < 4; ++cc) *(LAS v2u*)(Ss + (16 * w + l15) * SV + 16 * cc + 4 * g) = (v2u){pk2(sacc[cc][0], sacc[cc][1]), pk2(sacc[cc][2], sacc[cc][3])}; \
            __syncthreads(); \
            if ((step) + 2 < 64) SCAN_ISSUE(S_, (step) + 2); \
              \
            const int si = w >> 1, tj0 = 2 * (w & 1); \
            bf16x8 bq[2][4]; \
            _Pragma("unroll") for (int j = 0; j < 2; ++j) _Pragma("unroll") for (int ks = 0; ks < 4; ++ks) bq[j][ks] = *(const LAS bf16x8*)(QT + (16 * (tj0 + j) + l15) * SQ + 32 * ks + 8 * g); \
            { bf16x8 ak[4]; \
                _Pragma("unroll") for (int ks = 0; ks < 4; ++ks) ak[ks] = *(const LAS bf16x8*)(KTs + (16 * si + l15) * SQ + 32 * ks + 8 * g); \
                _Pragma("unroll") for (int j = 0; j < 2; ++j) { f32x4 d = {0.f, 0.f, 0.f, 0.f}; \
                    _Pragma("unroll") for (int ks = 0; ks < 4; ++ks) d = MFMA16(ak[ks], bq[j][ks], d); \
                    const int t = 16 * (tj0 + j) + l15, s0 = 16 * si + 4 * g; \
                    _Pragma("unroll") for (int r = 0; r < 4; ++r) { const bool keep = dir ? (s0 + r >= t) : (s0 + r <= t); if (!keep) d[r] = 0.f; } \
                    *(LAS v2u*)(Ps + t * SV + s0) = (v2u){pk2(d[0], d[1]), pk2(d[2], d[3])}; } } \
            f32x4 oacc[2]; \
            { bf16x8 as_[4]; \
                _Pragma("unroll") for (int ks = 0; ks < 4; ++ks) { const s16x4 a0 = tr_read(Ss + (32 * ks + 8 * g + q4) * SV + 16 * si + 4 * p4), a1 = tr_read(Ss + (32 * ks + 8 * g + 4 + q4) * SV + 16 * si + 4 * p4); as_[ks] = cat4(a0, a1); } \
                _Pragma("unroll") for (int j = 0; j < 2; ++j) { f32x4 d = {0.f, 0.f, 0.f, 0.f}; \
                    _Pragma("unroll") for (int ks = 0; ks < 4; ++ks) d = MFMA16(as_[ks], bq[j][ks], d); \
                    oacc[j] = d; } } \
            __syncthreads(); \
              \
            { bf16x8 av[2]; \
                _Pragma("unroll") for (int ks = 0; ks < 2; ++ks) { const s16x4 a0 = tr_read(Vs + (32 * ks + 8 * g + q4) * SV + 16 * si + 4 * p4), a1 = tr_read(Vs + (32 * ks + 8 * g + 4 + q4) * SV + 16 * si + 4 * p4); av[ks] = cat4(a0, a1); } \
                _Pragma("unroll") for (int j = 0; j < 2; ++j) { const int t = 16 * (tj0 + j) + l15; \
                    _Pragma("unroll") for (int ks = 0; ks < 2; ++ks) { const bf16x8 bp = *(const LAS bf16x8*)(Ps + t * SV + 32 * ks + 8 * g); oacc[j] = MFMA16(av[ks], bp, oacc[j]); } \
                    *(v2u*)(OD + ((size_t)b * SEQ + (size_t)c * 64 + t) * 512 + h * 128 + vh * 64 + 16 * si + 4 * g) = (v2u){pk2(oacc[j][0], oacc[j][1]), pk2(oacc[j][2], oacc[j][3])}; } } \
            { const float el = EBLs[16 * w + l15]; \
                bf16x8 bk[2]; \
                _Pragma("unroll") for (int ks = 0; ks < 2; ++ks) { const s16x4 a0 = tr_read(KTs + (32 * ks + 8 * g + q4) * SQ + 16 * w + 4 * p4), a1 = tr_read(KTs + (32 * ks + 8 * g + 4 + q4) * SQ + 16 * w + 4 * p4); bk[ks] = cat4(a0, a1); } \
                _Pragma("unroll") for (int cc = 0; cc < 4; ++cc) { \
                    _Pragma("unroll") for (int ks = 0; ks < 2; ++ks) { const s16x4 a0 = tr_read(Vs + (32 * ks + 8 * g + q4) * SV + 16 * cc + 4 * p4), a1 = tr_read(Vs + (32 * ks + 8 * g + 4 + q4) * SV + 16 * cc + 4 * p4); \
                        sacc[cc] = MFMA16(cat4(a0, a1), bk[ks], sacc[cc]); } \
                    sacc[cc] = sacc[cc] * el; } } \
            __syncthreads(); \
        } while (0)
        for (int step = 0; step < 64; step += 2) { SCAN_STEP(st[0], step); SCAN_STEP(st[1], step + 1); }
#undef SCAN_STEP
#undef SCAN_ISSUE
    }
}

constexpr int NKEY = 320, NKEYV = 336, SK = 72;
__device__ __forceinline__ void attn_phase(LAS unsigned char* lds, unsigned char* ws, const float* sink, const float* att_norm, const float* hg_norm, int nblk, int bid, int tid) {
    asm volatile("" : "+v"(tid));
    LAS bf16* Ks = (LAS bf16*)lds;
    LAS bf16* Vs = Ks + NKEY * SK;
    LAS float* SSs = (LAS float*)(Vs + NKEYV * SK);
    const int lane = tid & 63, w = __builtin_amdgcn_readfirstlane(tid >> 6), g = lane >> 4, l15 = lane & 15, q4 = l15 >> 2, p4 = lane & 3;
    const bf16* QB = (const bf16*)(ws + WS_QB); const bf16* KB = (const bf16*)(ws + WS_KB); const bf16* VB = (const bf16*)(ws + WS_VB);
    bf16* CAT = (bf16*)(ws + WS_KK);
    const int hl = w >> 1, rh = w & 1;
    constexpr int NIT = MTOK / 64;
    __syncthreads();
    for (int p = tid; p < 16 * 8; p += NTHR) *(LAS v4u*)(Vs + (NKEY + (p >> 3)) * SK + 8 * (p & 7)) = (v4u){0u, 0u, 0u, 0u};
    v4u kreg[5], vreg[5];
#define ATT_PREFETCH(item_, kvh_) do { const int b_ = (item_) >> 6, q0_ = ((item_) & 63) * 64; const size_t rb_ = (size_t)b_ * SEQ; \
        _Pragma("unroll") for (int i = 0; i < 5; ++i) { const int p = tid + NTHR * i; const int kr = p >> 3, c8 = p & 7; int pos = q0_ - 128 + kr; pos = pos < 0 ? 0 : (pos > SEQ - 1 ? SEQ - 1 : pos); \
            const size_t off = (rb_ + pos) * 128 + (kvh_) * 64 + 8 * c8; kreg[i] = *(const v4u*)(KB + off); vreg[i] = *(const v4u*)(VB + off); } \
        _Pragma("unroll") for (int r2 = 0; r2 < 2; ++r2) _Pragma("unroll") for (int ks = 0; ks < 2; ++ks) bqn[r2][ks] = *(const bf16x8*)(QB + (rb_ + q0_ + 32 * rh + 16 * r2 + l15) * 512 + ((kvh_) * 4 + hl) * 64 + 32 * ks + 8 * g); } while (0)
    bf16x8 bqn[2][2];
    const float sk2a = sink[hl] * LOG2E, sk2b = sink[4 + hl] * LOG2E;
    if (bid < NIT) ATT_PREFETCH(bid, 0);
    for (int item = bid; item < NIT; item += nblk) {
        const int b = item >> 6, q0 = (item & 63) * 64;
        const size_t rbase = (size_t)b * SEQ;
        const bool edge = (q0 < 128) || (q0 + 64 + 128 > SEQ);
#pragma unroll 1
        for (int kvh = 0; kvh < 2; ++kvh) {
            const int head = kvh * 4 + hl;
            bf16x8 bqa[2][2];
#pragma unroll
            for (int r2 = 0; r2 < 2; ++r2) { bqa[r2][0] = bqn[r2][0]; bqa[r2][1] = bqn[r2][1]; }
            __syncthreads();
#pragma unroll
            for (int i = 0; i < 5; ++i) { const int p = tid + NTHR * i; const int kr = p >> 3, c8 = p & 7; *(LAS v4u*)(Ks + kr * SK + 8 * c8) = kreg[i]; *(LAS v4u*)(Vs + kr * SK + 8 * c8) = vreg[i]; }
            __syncthreads();
            asm volatile("" : "+v"(bqa[0][0]), "+v"(bqa[0][1]), "+v"(bqa[1][0]), "+v"(bqa[1][1]));
            { const int nitem = (kvh == 0) ? item : (item + nblk < NIT ? item + nblk : item); const int nkvh = kvh ^ 1; ATT_PREFETCH(nitem, nkvh); }
            const float sk2 = kvh ? sk2b : sk2a;
#pragma unroll 1
            for (int rt = 0; rt < 2; ++rt) {
                const int kt0 = 2 * rh + rt; const int rl = 16 * kt0 + l15;
                bf16x8 bq[2];
#pragma unroll
                for (int ks = 0; ks < 2; ++ks) bq[ks] = rt ? bqa[1][ks] : bqa[0][ks];
                const LAS bf16* Kw = Ks + (16 * kt0) * SK; const LAS bf16* Vw = Vs + (16 * kt0) * SK;
                f32x4 s[17];
                {
                    bf16x8 kf[1][4][2];
                    const LAS bf16* Kl = Kw + l15 * SK + 8 * g;
#define ATT_KLOAD(buf, grp) do { _Pragma("unroll") for (int j = 0; j < 4; ++j) { if (4 * (grp) + j < 17) { _Pragma("unroll") for (int ks = 0; ks < 2; ++ks) kf[buf][j][ks] = *(const LAS bf16x8*)(Kl + (16 * (4 * (grp) + j)) * SK + 32 * ks); } } } while (0)
#define ATT_KMMA(buf, grp) do { _Pragma("unroll") for (int j = 0; j < 4; ++j) { if (4 * (grp) + j < 17) { f32x4 d = {0.f, 0.f, 0.f, 0.f}; _Pragma("unroll") for (int ks = 0; ks < 2; ++ks) d = MFMA16(kf[buf][j][ks], bq[ks], d); s[4 * (grp) + j] = d; } } } while (0)
#define ATT_SB() __builtin_amdgcn_sched_barrier(0)
                    ATT_KLOAD(0, 0); ATT_SB(); ATT_KMMA(0, 0); ATT_SB(); ATT_KLOAD(0, 1); ATT_SB(); ATT_KMMA(0, 1); ATT_SB(); ATT_KLOAD(0, 2); ATT_SB(); ATT_KMMA(0, 2); ATT_SB();
                    ATT_KLOAD(0, 3); ATT_SB(); ATT_KMMA(0, 3); ATT_SB(); ATT_KLOAD(0, 4); ATT_SB(); ATT_KMMA(0, 4); ATT_SB();
#undef ATT_KLOAD
#undef ATT_KMMA
                }
#pragma unroll
                for (int r = 0; r < 4; ++r) { if (4 * g + r - l15 < 0) s[0][r] = -1e30f; if (4 * g + r - l15 > 0) s[16][r] = -1e30f; }
                if (edge) {
#pragma unroll
                    for (int i = 0; i < 17; ++i)
#pragma unroll
                        for (int r = 0; r < 4; ++r) { const int kpos = q0 - 128 + 16 * (kt0 + i) + 4 * g + r; if (kpos < 0 || kpos >= SEQ) s[i][r] = -1e30f; } }
                float mx = sk2;
#pragma unroll
                for (int i = 0; i < 17; ++i) mx = fmaxf(fmaxf(mx, fmaxf(s[i][0], s[i][1])), fmaxf(s[i][2], s[i][3]));
                mx = fmaxf(mx, __shfl_xor(mx, 16)); mx = fmaxf(mx, __shfl_xor(mx, 32));
                float sum = 0.f;
#pragma unroll
                for (int i = 0; i < 17; ++i)
#pragma unroll
                    for (int r = 0; r < 4; ++r) { const float pv = __builtin_amdgcn_exp2f(s[i][r] - mx); s[i][r] = pv; sum += pv; }
                sum += __shfl_xor(sum, 16); sum += __shfl_xor(sum, 32);
                const float inv = __builtin_amdgcn_rcpf(sum + __builtin_amdgcn_exp2f(sk2 - mx));
                f32x4 O[4];
#pragma unroll
                for (int dt = 0; dt < 4; ++dt) O[dt] = (f32x4){0.f, 0.f, 0.f, 0.f};
                {
                    s16x4 vfr[1][4][2];
                    const LAS bf16* Vl = Vw + (4 * g + q4) * SK + 4 * p4;
#define ATT_VLOAD(buf, st) do { _Pragma("unroll") for (int dt = 0; dt < 4; ++dt) { vfr[buf][dt][0] = tr_read(Vl + (32 * (st)) * SK + 16 * dt); vfr[buf][dt][1] = tr_read(Vl + (32 * (st) + 16) * SK + 16 * dt); } } while (0)
#define ATT_PV(buf, st) do { v4u pw; pw.x = pk2(s[2 * (st)][0], s[2 * (st)][1]); pw.y = pk2(s[2 * (st)][2], s[2 * (st)][3]); \
                        if ((st) < 8) { pw.z = pk2(s[(st) < 8 ? 2 * (st) + 1 : 0][0], s[(st) < 8 ? 2 * (st) + 1 : 0][1]); pw.w = pk2(s[(st) < 8 ? 2 * (st) + 1 : 0][2], s[(st) < 8 ? 2 * (st) + 1 : 0][3]); } else { pw.z = 0u; pw.w = 0u; } \
                        const bf16x8 bp = __builtin_bit_cast(bf16x8, pw); \
                        _Pragma("unroll") for (int dt = 0; dt < 4; ++dt) O[dt] = MFMA16(cat4(vfr[buf][dt][0], vfr[buf][dt][1]), bp, O[dt]); } while (0)
                    ATT_VLOAD(0, 0); ATT_SB(); ATT_PV(0, 0); ATT_SB();
                    ATT_VLOAD(0, 1); ATT_SB(); ATT_PV(0, 1); ATT_SB();
                    ATT_VLOAD(0, 2); ATT_SB(); ATT_PV(0, 2); ATT_SB();
                    ATT_VLOAD(0, 3); ATT_SB(); ATT_PV(0, 3); ATT_SB();
                    ATT_VLOAD(0, 4); ATT_SB(); ATT_PV(0, 4); ATT_SB();
                    ATT_VLOAD(0, 5); ATT_SB(); ATT_PV(0, 5); ATT_SB();
                    ATT_VLOAD(0, 6); ATT_SB(); ATT_PV(0, 6); ATT_SB();
                    ATT_VLOAD(0, 7); ATT_SB(); ATT_PV(0, 7); ATT_SB();
                    ATT_VLOAD(0, 8); ATT_SB(); ATT_PV(0, 8); ATT_SB();
#undef ATT_VLOAD
#undef ATT_PV
#undef ATT_SB
                }
                float ssq = 0.f;
#pragma unroll
                for (int dt = 0; dt < 4; ++dt) { O[dt] = O[dt] * inv;
                    const v2u ow = (v2u){pk2(O[dt][0], O[dt][1]), pk2(O[dt][2], O[dt][3])};
                    *(v2u*)(CAT + (rbase + q0 + rl) * 1024 + head * 64 + 16 * dt + 4 * g) = ow;
                    const float a = bf_lo(ow.x), b2 = bf_hi(ow.x), c = bf_lo(ow.y), d = bf_hi(ow.y); ssq += (a * a + b2 * b2) + (c * c + d * d); }
                ssq += __shfl_xor(ssq, 16); ssq += __shfl_xor(ssq, 32);
                if (g == 0) SSs[rl * 8 + head] = ssq;
            }
        }
        asm volatile("s_waitcnt vmcnt(0)" ::: "memory");
        __syncthreads();
        { const bf16* OF = (const bf16*)(ws + WS_Y); const bf16* OBk = OF + (size_t)MTOK * 512; const bf16* HG = (const bf16*)(ws + WS_HG);
            const f32x4 w0 = *(const f32x4*)(hg_norm + 8 * l15), w1 = *(const f32x4*)(hg_norm + 8 * l15 + 4);
            const f32x4 n0 = *(const f32x4*)(att_norm + 8 * lane), n1 = *(const f32x4*)(att_norm + 8 * lane + 4);
            v4u la[8], lb[8], lg[8], lc[8];
#pragma unroll
            for (int i = 0; i < 8; ++i) { const size_t row = rbase + q0 + 8 * w + i; const size_t off = row * 512 + 8 * lane;
                la[i] = *(const v4u*)(OF + off); lb[i] = *(const v4u*)(OBk + off); lg[i] = *(const v4u*)(HG + off); lc[i] = *(const v4u*)(CAT + row * 1024 + 8 * lane); }
#pragma unroll
            for (int i = 0; i < 8; ++i) { const int rl = 8 * w + i; const size_t row = rbase + q0 + rl;
                const v4u a = la[i], bb = lb[i], gg = lg[i], ar = lc[i];
                const LAS f32x4* sp = (const LAS f32x4*)(SSs + rl * 8); const f32x4 t0 = sp[0], t1 = sp[1];
                const float rna = __builtin_amdgcn_rsqf((((t0[0] + t0[1]) + (t0[2] + t0[3])) + ((t1[0] + t1[1]) + (t1[2] + t1[3]))) * (1.f / 512.f) + EPS);
                v4u ao; ao.x = pk2(bf_lo(ar.x) * rna * n0[0], bf_hi(ar.x) * rna * n0[1]); ao.y = pk2(bf_lo(ar.y) * rna * n0[2], bf_hi(ar.y) * rna * n0[3]);
                ao.z = pk2(bf_lo(ar.z) * rna * n1[0], bf_hi(ar.z) * rna * n1[1]); ao.w = pk2(bf_lo(ar.w) * rna * n1[2], bf_hi(ar.w) * rna * n1[3]);
                *(v4u*)(CAT + row * 1024 + 8 * lane) = ao;
                float v[8]; v[0] = bf_lo(a.x) + bf_lo(bb.x); v[1] = bf_hi(a.x) + bf_hi(bb.x); v[2] = bf_lo(a.y) + bf_lo(bb.y); v[3] = bf_hi(a.y) + bf_hi(bb.y);
                v[4] = bf_lo(a.z) + bf_lo(bb.z); v[5] = bf_hi(a.z) + bf_hi(bb.z); v[6] = bf_lo(a.w) + bf_lo(bb.w); v[7] = bf_hi(a.w) + bf_hi(bb.w);
                float ss = 0.f;
#pragma unroll
                for (int e2 = 0; e2 < 8; ++e2) ss += v[e2] * v[e2];
                ss = row16_sum(ss);
                const float rn = __builtin_amdgcn_rsqf(ss * (1.f / 128.f) + EPS);
                v4u o; o.x = pk2(v[0] * rn * w0[0] * bf_lo(gg.x), v[1] * rn * w0[1] * bf_hi(gg.x)); o.y = pk2(v[2] * rn * w0[2] * bf_lo(gg.y), v[3] * rn * w0[3] * bf_hi(gg.y));
                o.z = pk2(v[4] * rn * w1[0] * bf_lo(gg.z), v[5] * rn * w1[1] * bf_hi(gg.z)); o.w = pk2(v[6] * rn * w1[2] * bf_lo(gg.w), v[7] * rn * w1[3] * bf_hi(gg.w));
                *(v4u*)(CAT + row * 1024 + 512 + 8 * lane) = o; } }
    }
#undef ATT_PREFETCH
}

__global__ void __launch_bounds__(NTHR, 2) fwd_mega(Params P) {
    extern __shared__ __attribute__((aligned(16))) unsigned char lds_raw[];
    cg::grid_group grid = cg::this_grid();
    LAS unsigned char* lds = (LAS unsigned char*)lds_raw;
    const int tid = threadIdx.x, lane = tid & 63, wave = __builtin_amdgcn_readfirstlane(tid >> 6);
    volatile LAS unsigned* MISC = (volatile LAS unsigned*)(lds + 131072 + 8192);
    if (tid < 16) MISC[tid] = 0u;
    __syncthreads();
    XcdBarrier xbar = xcd_barrier_post((unsigned*)P.ws, MISC + 8);
#define FAST_SYNC() xcd_barrier(xbar)
    const int G = gridDim.x, bid = blockIdx.x;
    const int gw = bid * NWAVES + wave, NGW = G * NWAVES;
    unsigned char* ws = P.ws;
    const float* x = P.in[0];
    bf16* XN = (bf16*)(ws + WS_XN); bf16* Y = (bf16*)(ws + WS_Y); bf16* H = (bf16*)(ws + WS_H);
    float* rope = (float*)(ws + WS_ROPE); float* R2 = (float*)(ws + WS_SS2); unsigned* CNT = (unsigned*)ws; float* XB = (float*)(ws + WS_XB);
    bf16* XN2 = (bf16*)(ws + WS_Y);

    constexpr int I_GU = (D_MODEL / 64) * (D_FF / 32), I_D = (D_FF / 64) * (D_MODEL / 32), I_IN = (D_MODEL / 64) * (IN_WIDTH / 32), I_OUT = (D_MODEL / 64) * (D_MODEL / 32);
    constexpr int NITEMS = 4 * I_GU + 2 * I_D + I_IN + I_OUT;
    LAS float* scr = (LAS float*)(lds + wave * 16384);
    {
#define TRANSPOSE_RANGE(lo_, hi_) do { for (int it = (lo_) + gw; it < (hi_); it += NGW) { int r = it; \
            if (r < I_GU) { transpose_item(P.in[3], D_MODEL, D_FF, (bf16*)(ws + WS_W1GU), 1, scr, r, lane, P.in[1]); continue; } r -= I_GU; \
            if (r < I_GU) { transpose_item(P.in[4], D_MODEL, D_FF, (bf16*)(ws + WS_W1GU), 2, scr, r, lane, P.in[1]); continue; } r -= I_GU; \
            if (r < I_D) { transpose_item(P.in[5], D_FF, D_MODEL, (bf16*)(ws + WS_W1D), 0, scr, r, lane); continue; } r -= I_D; \
            if (r < I_IN) { transpose_item(P.in[8], D_MODEL, IN_WIDTH, (bf16*)(ws + WS_WIN), 0, scr, r, lane, P.in[6]); continue; } r -= I_IN; \
            if (r < I_OUT) { transpose_item(P.in[14], D_MODEL, D_MODEL, (bf16*)(ws + WS_WOUT), 0, scr, r, lane); continue; } r -= I_OUT; \
            if (r < I_GU) { transpose_item(P.in[17], D_MODEL, D_FF, (bf16*)(ws + WS_W2GU), 1, scr, r, lane, P.in[15]); continue; } r -= I_GU; \
            if (r < I_GU) { transpose_item(P.in[18], D_MODEL, D_FF, (bf16*)(ws + WS_W2GU), 2, scr, r, lane, P.in[15]); continue; } r -= I_GU; \
            transpose_item(P.in[19], D_FF, D_MODEL, (bf16*)(ws + WS_W2D), 0, scr, r, lane); } } while (0)
        for (int i = bid * NTHR + tid; i < SEQ * 8; i += G * NTHR) { const int pos = i >> 3, j = i & 7;
            const double th = j == 0 ? 1.0 : j == 1 ? 0.19392274474868576 : j == 2 ? 0.03760603093086393 : j == 3 ? 0.007292664737217109 : j == 4 ? 0.001414213562373095 : j == 5 ? 0.0002742481756762073 : j == 6 ? 5.318295896944988e-05 : 1.031338537721246e-05;
            const double ang = (double)pos * th; const double nn = __builtin_rint(ang * 0.15915494309189535); const double r = __builtin_fma(-nn, 2.4492935982947064e-16, __builtin_fma(-nn, 6.283185307179586, ang)); const double r2 = r * r;
            double sn = 1.0, cs = 1.0;
            for (int k = 15; k >= 1; --k) { sn = 1.0 - r2 * sn / (double)((2 * k) * (2 * k + 1)); cs = 1.0 - r2 * cs / (double)((2 * k - 1) * (2 * k)); }
            rope[pos * 16 + j] = (float)cs; rope[pos * 16 + 8 + j] = (float)(r * sn); }
#pragma unroll 1
        for (int qd = 0; qd < 4; ++qd) { const int tlo = (NITEMS * qd) / 4, thi = (NITEMS * (qd + 1)) / 4, mlo = (MTOK / 4) * qd, mhi = (MTOK / 4) * (qd + 1);
            if (wave & 1) { row_pass2<0>(x, XN, nullptr, nullptr, 0.f, nullptr, R2, gw, NGW, lane, mlo, mhi); TRANSPOSE_RANGE(tlo, thi); }
            else { TRANSPOSE_RANGE(tlo, thi); row_pass2<0>(x, XN, nullptr, nullptr, 0.f, nullptr, R2, gw, NGW, lane, mlo, mhi); } }
    }
    if (P.ws == nullptr) grid.sync();
    FAST_SYNC();
    if (tid == 0) *(volatile LAS int*)(lds + 131072 + 4096 + 1024) = -1;
    __syncthreads();
    { pg8::Gemm g{XN, (const bf16*)(ws + WS_W1GU), MTOK, 2 * D_FF, D_MODEL}; pg8::StaticOrder S; S.init(MTOK, 2 * D_FF, G, bid); pg8::EpiSwiGLU E{H, D_FF, R2};
      pg8::gemm_phase<pg8::EpiSwiGLU, pg8::StaticOrder, true, true>(lds, g, S, E);
#ifdef DUP_P1
      __syncthreads(); pg8::gemm_phase<pg8::EpiSwiGLU, pg8::StaticOrder, true, true>(lds, g, S, E);
#endif
    }
    FAST_SYNC();
    { pg8::Gemm g{H, (const bf16*)(ws + WS_W1D), MTOK, D_MODEL, D_FF}; pg8::StaticOrder S; S.init(MTOK, D_MODEL, G, bid);
      pg8::EpiNormRes2 E{XN, nullptr, P.in[2], 0.5f, XB, CNT + 4096, R2};
      pg8::gemm_phase<pg8::EpiNormRes2, pg8::StaticOrder, true, true>(lds, g, S, E); }
    FAST_SYNC();
    if (tid == 0) *(volatile LAS int*)(lds + 131072 + 4096 + 1024) = -1;
    __syncthreads();
    { pg8::Gemm g{XN, (const bf16*)(ws + WS_WIN), MTOK, IN_WIDTH, D_MODEL}; pg8::StaticOrder S; S.init(MTOK, IN_WIDTH, G, bid);
      pg8::EpiMixer E{ws, R2, P.in[11], P.in[12]};
#ifndef NO_MIX
      { LAS float* lbt = (LAS float*)(lds + 131072);
        for (int i = tid; i < 1024; i += NTHR) { const float* lr = (i >> 9) ? P.in[12] : P.in[11]; const int cidx = i & 511; lbt[i] = __builtin_amdgcn_rcpf(1.0f + __expf(lr[512 + cidx] - lr[cidx])); }
        __syncthreads(); }
      pg8::gemm_phase<pg8::EpiMixer, pg8::StaticOrder, true, true>(lds, g, S, E);
#ifdef DUP_P4
      __syncthreads(); pg8::gemm_phase<pg8::EpiMixer, pg8::StaticOrder, true, true>(lds, g, S, E);
#endif
#endif
    }
    FAST_SYNC();
#ifndef NO_SCAN
    scan_phase(lds, ws, G, bid, tid);
#ifdef DUP_SCAN
    __syncthreads(); scan_phase(lds, ws, G, bid, tid);
#endif
#endif
    FAST_SYNC();
#ifndef NO_ATTN
    attn_phase(lds, ws, P.in[9], P.in[10], P.in[13], G, bid, tid);
#ifdef DUP_ATTN
    __syncthreads(); attn_phase(lds, ws, P.in[9], P.in[10], P.in[13], G, bid, tid);
#endif
#endif
    FAST_SYNC();
    { pg8::Gemm g{(const bf16*)(ws + WS_KK), (const bf16*)(ws + WS_WOUT), MTOK, D_MODEL, D_MODEL}; pg8::StaticOrder S; S.init(MTOK, D_MODEL, G, bid);
      pg8::EpiNormRes2 E{XN, nullptr, P.in[7], 1.0f, XB + (size_t)MTOK * 4, CNT + 4096 + 256 * 64, R2};
      pg8::gemm_phase<pg8::EpiNormRes2, pg8::StaticOrder, true, true>(lds, g, S, E); }
    FAST_SYNC();
    if (tid == 0) *(volatile LAS int*)(lds + 131072 + 4096 + 1024) = -1;
    __syncthreads();
    { pg8::Gemm g{XN, (const bf16*)(ws + WS_W2GU), MTOK, 2 * D_FF, D_MODEL}; pg8::StaticOrder S; S.init(MTOK, 2 * D_FF, G, bid); pg8::EpiSwiGLU E{H, D_FF, R2};
      pg8::gemm_phase<pg8::EpiSwiGLU, pg8::StaticOrder, true, true>(lds, g, S, E); }
    FAST_SYNC();
    { pg8::Gemm g{H, (const bf16*)(ws + WS_W2D), MTOK, D_MODEL, D_FF}; pg8::StaticOrder S; S.init(MTOK, D_MODEL, G, bid);
      pg8::EpiNormRes2 E{XN, P.out, P.in[16], 0.5f, XB + (size_t)2 * MTOK * 4, CNT + 4096 + 2 * 256 * 64, R2};
      pg8::gemm_phase<pg8::EpiNormRes2, pg8::StaticOrder, true, true>(lds, g, S, E); }
}

extern "C" void kernel_launch(void* const* d_in, const int* in_sizes, int n_in, void* d_out, int out_size, void* d_ws, size_t ws_size, hipStream_t stream) {
    static int grid = 0;
    if (grid == 0) {
        if (n_in != 20 || ws_size < WS_END) { fprintf(stderr, "kernel_launch: unexpected n_in %d / ws %zu\n", n_in, ws_size); grid = -1; return; }
        int dev = 0, cus = 0, per_cu = 0;
        hipGetDevice(&dev); hipDeviceGetAttribute(&cus, hipDeviceAttributeMultiprocessorCount, dev);
        hipFuncSetAttribute((const void*)fwd_mega, hipFuncAttributeMaxDynamicSharedMemorySize, LDS_BYTES);
        hipOccupancyMaxActiveBlocksPerMultiprocessor(&per_cu, (const void*)fwd_mega, NTHR, LDS_BYTES);
        if (per_cu < 1) { fprintf(stderr, "kernel_launch: occupancy query gave %d\n", per_cu); per_cu = 1; }
        grid = cus * 1;
        (void)hipGetLastError();
    }
    if (grid < 0) return;
    if (hipMemsetAsync(d_ws, 0, CTL_BYTES, stream) != hipSuccess) { fprintf(stderr, "memset failed\n"); return; }
    if (hipMemsetAsync((unsigned char*)d_ws + WS_XB, 0xFF, (size_t)3 * MTOK * 4 * sizeof(float), stream) != hipSuccess) { fprintf(stderr, "memset 2 failed\n"); return; }
    Params p{};
    for (int i = 0; i < 20; ++i) p.in[i] = (const float*)d_in[i];
    p.out = (float*)d_out; p.ws = (unsigned char*)d_ws;
    void* args[] = {&p};
    hipError_t e = hipLaunchCooperativeKernel((const void*)fwd_mega, dim3(grid), dim3(NTHR), args, LDS_BYTES, stream);
    if (e != hipSuccess) fprintf(stderr, "cooperative launch failed: %s (grid %d)\n", hipGetErrorString(e), grid);
}
```

```cpp
#include <hip/hip_runtime.h>
#include <hip/hip_cooperative_groups.h>
#include <cstdio>
#include <cstdint>
namespace cg = cooperative_groups;

constexpr int D_MODEL = 1024, BATCH = 16, SEQ = 4096, MTOK = BATCH * SEQ;
constexpr int D_FF = 2816, IN_WIDTH = 3328;
constexpr float EPS = 1e-6f;
constexpr float LOG2E = 1.4426950408889634f;
constexpr float QSCALE = 0.125f * LOG2E;

constexpr size_t MiB = 1u << 20;
constexpr size_t WS_ROPE = 1 * MiB;
constexpr size_t WS_W1GU = 2 * MiB, WS_W1D = 13 * MiB, WS_WIN = 19 * MiB, WS_WOUT = 26 * MiB, WS_W2GU = 28 * MiB, WS_W2D = 39 * MiB;
constexpr size_t WS_XN = 48 * MiB;
constexpr size_t WS_Y = 176 * MiB;
constexpr size_t WS_H = 304 * MiB;
constexpr size_t WS_QB = 304 * MiB, WS_KB = 368 * MiB, WS_VB = 384 * MiB, WS_HQ = 400 * MiB, WS_HV = 464 * MiB, WS_HG = 528 * MiB;
constexpr size_t WS_KT = 592 * MiB, WS_KK = 720 * MiB, WS_EB = 848 * MiB;
constexpr size_t WS_EBL = 976 * MiB;
constexpr size_t WS_XB = 980 * MiB;
constexpr size_t WS_SS2 = 984 * MiB;
constexpr size_t WS_END = 985 * MiB;
constexpr size_t CTL_BYTES = 262144;
constexpr int LDS_BYTES = 147456;

namespace pg8 {
#define PG8_LAS __attribute__((address_space(3)))
typedef unsigned short bf16_t;
typedef short bf16x8 __attribute__((ext_vector_type(8)));
typedef float f32x4 __attribute__((ext_vector_type(4)));
typedef unsigned u32x4 __attribute__((ext_vector_type(4)));
constexpr int BM = 256, BK = 64, HALF = 128, HTB = HALF * BK * 2  , STAGE_BYTES = 8 * HTB, NXCD = 8, WGM = 8;

__host__ __device__ __forceinline__ int lds_byte(int r, int c) { const int st = (r >> 4) * 2 + (c >> 5), rr = r & 15, cc = c & 31, ob = rr * 64 + cc * 2; return st * 1024 + (ob ^ (((ob >> 9) & 1) << 5)); }
__host__ __device__ __forceinline__ void stage_rc(int b, int& R, int& C) { const int st = b / 1024, sb = b % 1024, swz = sb ^ (((sb >> 9) & 1) << 5); R = (st >> 1) * 16 + swz / 64; C = (st & 1) * 32 + (swz % 64) / 2; }
__host__ __device__ __forceinline__ int perm32(int rho) { const int n = rho >> 4, i = rho & 15; return 8 * (i >> 2) + 4 * n + (i & 3); }

struct Unit { int pm, pn; };
struct Gemm { const bf16_t* A; const bf16_t* Bt; int M, N, K; };

struct StaticOrder {
    int nM, nN, nwg, G, c;
    __host__ __device__ void init(int M, int N, int G_, int c_) { nM = M / BM; nN = N / BM; nwg = nM * nN; G = G_; c = c_; }
    __host__ __device__ bool next(int i, Unit& u) const {
        const long L = (long)i * G + c; if (L >= nwg) return false;
        int wgid = (int)L; { const int q = nwg / NXCD, r = nwg % NXCD, xcd = wgid % NXCD, off = wgid / NXCD; wgid = (xcd < r ? xcd * (q + 1) : r * (q + 1) + (xcd - r) * q) + off; }
        const int nig = WGM * nN, gid = wgid / nig, fm = gid * WGM, gsz = (nM - fm) < WGM ? (nM - fm) : WGM;
        u.pm = fm + ((wgid % nig) % gsz); u.pn = (wgid % nig) / gsz; return true;
    }
    __device__ __forceinline__ void a_ready(const Unit&) const {}
    __device__ __forceinline__ void done(const Unit&) const {}
};
typedef unsigned u32x2 __attribute__((ext_vector_type(2)));
typedef float f32x2_t __attribute__((ext_vector_type(2))); typedef __bf16 bf16x2_t __attribute__((ext_vector_type(2)));
__device__ __forceinline__ unsigned cvt_pk_bf16(float lo, float hi) { f32x2_t v = {lo, hi}; bf16x2_t b = __builtin_convertvector(v, bf16x2_t); return __builtin_bit_cast(unsigned, b); }
__device__ __forceinline__ void store8(bf16_t* p, const f32x4 v0, const f32x4 v1) {
    u32x4 w; w.x = cvt_pk_bf16(v0[0], v0[1]); w.y = cvt_pk_bf16(v0[2], v0[3]); w.z = cvt_pk_bf16(v1[0], v1[1]); w.w = cvt_pk_bf16(v1[2], v1[3]); *(u32x4*)p = w; }
__device__ __forceinline__ void store4(bf16_t* p, const f32x4 v0) { u32x2 w; w.x = cvt_pk_bf16(v0[0], v0[1]); w.y = cvt_pk_bf16(v0[2], v0[3]); *(u32x2*)p = w; }
__device__ __forceinline__ float fsigmoid(float x) { return __builtin_amdgcn_rcpf(1.0f + __builtin_amdgcn_exp2f(-1.4426950408889634f * x)); }
__device__ __forceinline__ f32x4 sigmoid4(f32x4 v) { return (f32x4){fsigmoid(v[0]), fsigmoid(v[1]), fsigmoid(v[2]), fsigmoid(v[3])}; }

__device__ __forceinline__ float row_rs(const float* ss4, int row) { const f32x4 p = *(const f32x4*)(ss4 + (unsigned)(row * 4)); return __builtin_amdgcn_rsqf(((p[0] + p[1]) + (p[2] + p[3])) * (1.0f / 1024.0f) + 1e-6f); }
__device__ __forceinline__ const PG8_LAS float* row_scale_table(const float* ss4, int pm, PG8_LAS unsigned char* ldse, int wid, int lane) {
    PG8_LAS float* rst = (PG8_LAS float*)(ldse + 4096); volatile PG8_LAS int* tag = (volatile PG8_LAS int*)(ldse + 4096 + 1024);
    if (*tag != pm) {
        const int t_ = wid * 64 + lane; if (t_ < 256) rst[t_] = row_rs(ss4, pm * BM + t_);
        asm volatile("s_waitcnt lgkmcnt(0)" ::: "memory"); __builtin_amdgcn_s_barrier(); asm volatile("" ::: "memory");
        if (t_ == 0) *tag = pm;
    }
    return rst;
}
struct EpiPlain {
    static constexpr bool PERM = true, AFTER_DRAIN = false;
    bf16_t* O; int ldc;
    __device__ __forceinline__ void operator()(const f32x4 (&acc)[2][2][4][2], const Unit& u, int wr, int wc, int fr, int fq, PG8_LAS unsigned char*, int, int) const {
        const int row0 = u.pm * BM + wr * 64 + fr, col0 = u.pn * BM + wc * 32 + 8 * fq;
#pragma unroll
        for (int ai = 0; ai < 2; ++ai)
#pragma unroll
            for (int m = 0; m < 4; ++m) { bf16_t* rowp = O + (size_t)(row0 + ai * HALF + m * 16) * ldc + col0;
#pragma unroll
                for (int bj = 0; bj < 2; ++bj) store8(rowp + bj * HALF, acc[ai][bj][m][0], acc[ai][bj][m][1]); }
    }
};
struct EpiSwiGLU {
    static constexpr bool PERM = true, AFTER_DRAIN = false;
    bf16_t* H; int ldh; const float* ss2;
    __device__ __forceinline__ void operator()(const f32x4 (&acc)[2][2][4][2], const Unit& u, int wr, int wc, int fr, int fq, PG8_LAS unsigned char* ldse, int wid, int lane_) const {
        const int row0 = u.pm * BM + wr * 64 + fr, col0 = u.pn * HALF + wc * 32 + 8 * fq;
        const PG8_LAS float* rsl = row_scale_table(ss2, u.pm, ldse, wid, lane_) + wr * 64 + fr;
#pragma unroll
        for (int ai = 0; ai < 2; ++ai)
#pragma unroll
            for (int m = 0; m < 4; ++m) { bf16_t* rowp = H + (size_t)(row0 + ai * HALF + m * 16) * ldh + col0;
                const float rs = rsl[ai * HALF + m * 16];
                const f32x4 g0 = acc[ai][0][m][0] * rs, g1 = acc[ai][0][m][1] * rs, u0 = acc[ai][1][m][0] * rs, u1 = acc[ai][1][m][1] * rs;
                store8(rowp, g0 * sigmoid4(g0) * u0, g1 * sigmoid4(g1) * u1); }
    }
};
struct EpiMixer {
    static constexpr bool PERM = true, AFTER_DRAIN = false;
    unsigned char* ws; const float* ss2;
    const float *lbf, *lbb;
    __device__ __forceinline__ void operator()(const f32x4 (&acc)[2][2][4][2], const Unit& u, int wr, int wc, int fr, int fq, PG8_LAS unsigned char* ldse, int wid, int lane_) const {
        const int pn = u.pn; const int row0 = u.pm * BM + wr * 64 + fr; const int cl0 = wc * 32 + 8 * fq;
        const PG8_LAS float* rsl = row_scale_table(ss2, u.pm, ldse, wid, lane_) + wr * 64 + fr;
        bf16_t* const QB = (bf16_t*)(ws + WS_QB); bf16_t* const KB = (bf16_t*)(ws + WS_KB); bf16_t* const VB = (bf16_t*)(ws + WS_VB); bf16_t* const HQ = (bf16_t*)(ws + WS_HQ);
        bf16_t* const HV = (bf16_t*)(ws + WS_HV); bf16_t* const HG = (bf16_t*)(ws + WS_HG); const float* const rope = (const float*)(ws + WS_ROPE);
        if (pn <= 2) {
#ifndef NO_B1
            float rsa[2][4];
#pragma unroll
            for (int ai = 0; ai < 2; ++ai)
#pragma unroll
                for (int m = 0; m < 4; ++m) rsa[ai][m] = rsl[ai * HALF + m * 16];
            const bool rotw = (wc & 1) == 0;
#pragma unroll
            for (int ai = 0; ai < 2; ++ai)
#pragma unroll
                for (int m = 0; m < 4; ++m) { const int row = row0 + ai * HALF + m * 16; const int pos = row & (SEQ - 1); const float rsr = rsa[ai][m];
                    f32x4 c0 = {1.f, 1.f, 1.f, 1.f}, c1 = c0, s0 = {0.f, 0.f, 0.f, 0.f}, s1 = s0;
                    if (rotw && fq < 2) { const f32x4* rp = (const f32x4*)(rope + pos * 16); c0 = rp[0]; c1 = rp[1]; s0 = rp[2]; s1 = rp[3]; if (fq == 0) { s0 = -s0; s1 = -s1; } }
#pragma unroll
                    for (int bj = 0; bj < 2; ++bj) { f32x4 v0 = acc[ai][bj][m][0] * rsr, v1 = acc[ai][bj][m][1] * rsr;
                        const bool dorot = rotw && !(pn == 2 && bj == 1);
                        if (dorot) { f32x4 p0, p1;
#pragma unroll
                            for (int i = 0; i < 4; ++i) { p0[i] = __shfl_xor(v0[i], 16); p1[i] = __shfl_xor(v1[i], 16); }
                            v0 = v0 * c0 + p0 * s0; v1 = v1 * c1 + p1 * s1; }
                        if (pn < 2) { v0 = v0 * QSCALE; v1 = v1 * QSCALE; store8(QB + (size_t)row * 512 + pn * 256 + bj * HALF + cl0, v0, v1); }
                        else if (bj == 0) store8(KB + (size_t)row * 128 + cl0, v0, v1);
                        else store8(VB + (size_t)row * 128 + cl0, v0, v1); }
                    if (m & 1) asm volatile("" ::: "memory"); }
#endif
        } else if (pn <= 4 || pn >= 9) {
#ifndef NO_B2
        float rsa[2][4];
#pragma unroll
        for (int ai = 0; ai < 2; ++ai)
#pragma unroll
            for (int m = 0; m < 4; ++m) rsa[ai][m] = rsl[ai * HALF + m * 16];
            bf16_t* dst = pn <= 4 ? HQ : (pn <= 10 ? HV : HG); const int cb = (pn <= 4 ? pn - 3 : (pn <= 10 ? pn - 9 : pn - 11)) * 256 + cl0; const bool mulx = pn >= 9;
#pragma unroll
            for (int ai = 0; ai < 2; ++ai)
#pragma unroll
                for (int m = 0; m < 4; ++m) { const int row = row0 + ai * HALF + m * 16; const float rsr = rsa[ai][m];
#pragma unroll
                    for (int bj = 0; bj < 2; ++bj) { f32x4 v0 = acc[ai][bj][m][0] * rsr, v1 = acc[ai][bj][m][1] * rsr; f32x4 a0 = sigmoid4(v0), a1 = sigmoid4(v1);
                        if (mulx) { a0 = a0 * v0; a1 = a1 * v1; }
                        store8(dst + (size_t)row * 512 + cb + bj * HALF, a0, a1); }
                    asm volatile("" ::: "memory"); }
#endif
        } else {
#ifndef NO_B3
            const int dir = (pn - 5) >> 1; const int cb = ((pn - 5) & 1) * 256 + cl0; const float* lbr = dir ? lbb : lbf;
            const size_t dstride = (size_t)MTOK * 512; bf16_t* kt = (bf16_t*)(ws + WS_KT) + dir * dstride; bf16_t* eb = (bf16_t*)(ws + WS_EB) + dir * dstride; float* ebl = (float*)(ws + WS_EBL) + (size_t)dir * (MTOK / 64) * 512;
            const int lane = fq * 16 + fr;
#pragma unroll
            for (int ai = 0; ai < 2; ++ai)
#pragma unroll
                for (int bj = 0; bj < 2; ++bj) { const int colg = cb + bj * HALF;
                  u32x4 ebp[4], ktp[4]; f32x4 eTa, eTb;
                  float rsr[4];
#pragma unroll
                  for (int m = 0; m < 4; ++m) rsr[m] = rsl[ai * HALF + m * 16];
#pragma unroll
                  for (int nh = 0; nh < 4; ++nh) { const int n = nh >> 1, eh = (nh & 1) * 2; const int col = colg + 4 * n + eh;
                    float lb[2];
#pragma unroll
                    for (int e = 0; e < 2; ++e) lb[e] = ((const PG8_LAS float*)ldse)[dir * 512 + col + e];
                    float G[4][2], KC[4][2];
#pragma unroll
                    for (int m = 0; m < 4; ++m) {
#pragma unroll
                        for (int e = 0; e < 2; ++e) { float x = acc[ai][bj][m][n][eh + e] * rsr[m]; asm volatile("" : "+v"(x)); const float f = lb[e] + (1.0f - lb[e]) * fsigmoid(x); G[m][e] = __builtin_amdgcn_logf(f); KC[m][e] = 1.0f - f; } }
                    float T[2];
#pragma unroll
                    for (int e = 0; e < 2; ++e) { float tot = 0.f;
#pragma unroll
                        for (int m = 0; m < 4; ++m) { float v = G[m][e];
                            v += __builtin_bit_cast(float, __builtin_amdgcn_update_dpp(0, __builtin_bit_cast(int, v), 0x111, 0xf, 0xf, true));
                            v += __builtin_bit_cast(float, __builtin_amdgcn_update_dpp(0, __builtin_bit_cast(int, v), 0x112, 0xf, 0xf, true));
                            v += __builtin_bit_cast(float, __builtin_amdgcn_update_dpp(0, __builtin_bit_cast(int, v), 0x114, 0xf, 0xf, true));
                            v += __builtin_bit_cast(float, __builtin_amdgcn_update_dpp(0, __builtin_bit_cast(int, v), 0x118, 0xf, 0xf, true));
                            const float rt = __builtin_bit_cast(float, __builtin_amdgcn_ds_bpermute(((lane | 15) << 2), __builtin_bit_cast(int, v)));
                            const float P = v + tot; tot += rt;
                            G[m][e] = dir ? (G[m][e] - P) : P; }
                        T[e] = tot; }
                    const float eT0 = __builtin_amdgcn_exp2f(T[0]), eT1 = __builtin_amdgcn_exp2f(T[1]);
                    if (nh < 2) { eTa[2 * nh] = eT0; eTa[2 * nh + 1] = eT1; } else { eTb[2 * nh - 4] = eT0; eTb[2 * nh - 3] = eT1; }
#pragma unroll
                    for (int m = 0; m < 4; ++m) {
                        const float b0 = dir ? G[m][0] + T[0] : G[m][0], b1 = dir ? G[m][1] + T[1] : G[m][1];
                        const float eb0 = __builtin_amdgcn_exp2f(b0), eb1 = __builtin_amdgcn_exp2f(b1);
                        const float kt0 = KC[m][0] * __builtin_amdgcn_rcpf(eb0), kt1 = KC[m][1] * __builtin_amdgcn_rcpf(eb1);
                        ebp[m][nh] = cvt_pk_bf16(eb0, eb1); ktp[m][nh] = cvt_pk_bf16(kt0, kt1);
                        asm volatile("" : "+v"(ebp[m]), "+v"(ktp[m])); }
                  }
#pragma unroll
                  for (int m = 0; m < 4; ++m) { const unsigned off = (unsigned)((row0 + ai * HALF + m * 16) * 512 + colg); *(u32x4*)(eb + off) = ebp[m]; *(u32x4*)(kt + off) = ktp[m]; }
                  if (fr == 0) { const int rowc = row0 + ai * HALF; float* p = ebl + (unsigned)((rowc >> 6) * 512 + colg); *(f32x4*)p = eTa; *(f32x4*)(p + 4) = eTb; }
                  asm volatile("" ::: "memory");
                }
#endif
        }
    }
};


struct EpiNormRes2 {
    static constexpr bool PERM = true, AFTER_DRAIN = false;
    bf16_t* xb; float* outf; const float* wpost; float scale;
    float* xbuf; unsigned* cnt; float* ss2;
    __device__ __forceinline__ void operator()(const f32x4 (&acc)[2][2][4][2], const Unit& u, int wr, int wc, int fr, int fq, PG8_LAS unsigned char* lds, int wid, int lane) const {
        PG8_LAS float* Pt = (PG8_LAS float*)lds;
        PG8_LAS float* St = Pt + 1024;
        const int tid = wid * 64 + lane;
        const int col0 = u.pn * BM + wc * 32 + 8 * fq;
        unsigned off0 = (unsigned)((u.pm * BM + wr * 64 + fr) * 1024 + col0); asm volatile("" : "+v"(off0));
        u32x2 bs[2][4][2][2]; f32x4 wv[2][2];
#pragma unroll
        for (int bj = 0; bj < 2; ++bj) { wv[bj][0] = *(const f32x4*)(wpost + col0 + bj * HALF); wv[bj][1] = *(const f32x4*)(wpost + col0 + bj * HALF + 4);
#pragma unroll
            for (int ai = 0; ai < 2; ++ai)
#pragma unroll
                for (int m = 0; m < 4; ++m) { const bf16_t* p_ = xb + off0 + (unsigned)((ai * HALF + m * 16) * 1024 + bj * HALF); bs[ai][m][bj][0] = *(const u32x2*)p_; bs[ai][m][bj][1] = *(const u32x2*)(p_ + 4); } }
#pragma unroll
        for (int ai = 0; ai < 2; ++ai)
#pragma unroll
            for (int m = 0; m < 4; ++m) { float s = 0.f;
#pragma unroll
                for (int bj = 0; bj < 2; ++bj)
#pragma unroll
                    for (int n = 0; n < 2; ++n) { const f32x4 x = acc[ai][bj][m][n]; s += (x[0] * x[0] + x[1] * x[1]) + (x[2] * x[2] + x[3] * x[3]); }
                s += __shfl_xor(s, 16); s += __shfl_xor(s, 32);
                if (fq == 0) Pt[(ai * HALF + wr * 64 + m * 16 + fr) * 4 + wc] = s; }
        asm volatile("s_waitcnt lgkmcnt(0)" ::: "memory"); __builtin_amdgcn_s_barrier(); asm volatile("" ::: "memory");
        if (tid < 256) { const f32x4 p = *(const PG8_LAS f32x4*)(Pt + tid * 4); const float tot = (p[0] + p[1]) + (p[2] + p[3]);
            float* sl = xbuf + (size_t)(u.pm * BM + tid) * 4;
            __hip_atomic_store(sl + u.pn, tot, __ATOMIC_RELAXED, __HIP_MEMORY_SCOPE_AGENT);
            float t0, t1, t2, t3; unsigned sp = 0;
            for (;;) {
                t0 = __hip_atomic_load(sl + 0, __ATOMIC_RELAXED, __HIP_MEMORY_SCOPE_AGENT); t1 = __hip_atomic_load(sl + 1, __ATOMIC_RELAXED, __HIP_MEMORY_SCOPE_AGENT);
                t2 = __hip_atomic_load(sl + 2, __ATOMIC_RELAXED, __HIP_MEMORY_SCOPE_AGENT); t3 = __hip_atomic_load(sl + 3, __ATOMIC_RELAXED, __HIP_MEMORY_SCOPE_AGENT);
                const int bad = (__builtin_bit_cast(int, t0) | __builtin_bit_cast(int, t1) | __builtin_bit_cast(int, t2) | __builtin_bit_cast(int, t3)) < 0;
                if (!__any(bad)) break;
                if (++sp > (1u << 16)) break;
                __builtin_amdgcn_s_sleep(1);
            }
            St[tid] = scale * __builtin_amdgcn_rsqf(((t0 + t1) + (t2 + t3)) * (1.0f / 1024.0f) + 1e-6f); }
        asm volatile("s_waitcnt vmcnt(0) lgkmcnt(0)" ::: "memory"); __builtin_amdgcn_s_barrier(); asm volatile("" ::: "memory");
        float q[2][4];
#pragma unroll
        for (int ai = 0; ai < 2; ++ai)
#pragma unroll
            for (int m = 0; m < 4; ++m) { const float r = St[ai * HALF + wr * 64 + m * 16 + fr]; float qq = 0.f;
#pragma unroll
                for (int bj = 0; bj < 2; ++bj) { const unsigned off = off0 + (unsigned)((ai * HALF + m * 16) * 1024 + bj * HALF); const u32x4 bw = {bs[ai][m][bj][0].x, bs[ai][m][bj][0].y, bs[ai][m][bj][1].x, bs[ai][m][bj][1].y};
                    const f32x4 b0 = {__builtin_bit_cast(float, bw.x << 16), __builtin_bit_cast(float, bw.x & 0xffff0000u), __builtin_bit_cast(float, bw.y << 16), __builtin_bit_cast(float, bw.y & 0xffff0000u)};
                    const f32x4 b1 = {__builtin_bit_cast(float, bw.z << 16), __builtin_bit_cast(float, bw.z & 0xffff0000u), __builtin_bit_cast(float, bw.w << 16), __builtin_bit_cast(float, bw.w & 0xffff0000u)};
                    const f32x4 x0 = b0 + acc[ai][bj][m][0] * wv[bj][0] * r, x1 = b1 + acc[ai][bj][m][1] * wv[bj][1] * r;
                    if (outf) { *(f32x4*)(outf + off) = x0; *(f32x4*)(outf + off + 4) = x1; }
                    else { u32x4 w; w.x = cvt_pk_bf16(x0[0], x0[1]); w.y = cvt_pk_bf16(x0[2], x0[3]); w.z = cvt_pk_bf16(x1[0], x1[1]); w.w = cvt_pk_bf16(x1[2], x1[3]); *(u32x4*)(xb + off) = w;
#pragma unroll
                        for (int k = 0; k < 4; ++k) { const float a = __builtin_bit_cast(float, w[k] << 16), b2 = __builtin_bit_cast(float, w[k] & 0xffff0000u); qq += a * a + b2 * b2; } } }
                q[ai][m] = qq; }
        if (!outf) {
#pragma unroll
            for (int ai = 0; ai < 2; ++ai)
#pragma unroll
                for (int m = 0; m < 4; ++m) { float s = q[ai][m]; s += __shfl_xor(s, 16); s += __shfl_xor(s, 32); if (fq == 0) Pt[(ai * HALF + wr * 64 + m * 16 + fr) * 4 + wc] = s; }
        }
        asm volatile("s_waitcnt lgkmcnt(0)" ::: "memory"); __builtin_amdgcn_s_barrier(); asm volatile("" ::: "memory");
        if (!outf && tid < 256) { const f32x4 p = *(const PG8_LAS f32x4*)(Pt + tid * 4); ss2[(unsigned)((u.pm * BM + tid) * 4 + u.pn)] = (p[0] + p[1]) + (p[2] + p[3]); }
    }
};
template <class Epi, class Sched, bool ALIGN_EPI = false, bool SP2 = false>
__device__ __forceinline__ void gemm_phase(PG8_LAS unsigned char* lds, const Gemm g, const Sched& S, const Epi& E) {
    int tid_ = threadIdx.x; asm volatile("" : "+v"(tid_));
    const int tid = tid_, wid = __builtin_amdgcn_readfirstlane(tid >> 6), lane = tid & 63, wr = wid >> 2, wc = wid & 3, fr = lane & 15, fq = lane >> 4;
    const int K = g.K, nt = K / BK;
    unsigned voffA[2], voffB[2];
#pragma unroll
    for (int i = 0; i < 2; ++i) { int R, C; stage_rc(tid * 16 + i * 8192, R, C); const int Rb = Epi::PERM ? ((R & ~31) + perm32(R & 31)) : R;
        voffA[i] = (unsigned)(R * K + C) * 2u; voffB[i] = (unsigned)(Rb * K + C) * 2u; }
    const size_t kstep = (size_t)(BK * 2);
    const size_t hstep = (size_t)HALF * K * 2;
    const size_t tstep = 2 * hstep;
    const unsigned ldsw = (unsigned)wid * 1024u;
    const int aoff = lds_byte(wr * 64 + fr, fq * 8), boff = lds_byte(wc * 32 + fr, fq * 8);
#define PG8_SA(b, h) (((b) * 2 + (h)) * HTB)
#define PG8_SB(b, h) ((4 + (b) * 2 + (h)) * HTB)
#define PG8_STAGE(bufoff, gbase, voff) do { _Pragma("unroll") for (int _i = 0; _i < 2; ++_i) \
        __builtin_amdgcn_global_load_lds((const unsigned*)((const char*)(gbase) + (voff)[_i]), (PG8_LAS unsigned*)(lds + (bufoff) + ldsw + _i * 8192), 16, 0, 0); } while (0)
#define PG8_LDA(dst, b, h) do { _Pragma("unroll") for (int m = 0; m < 4; ++m) _Pragma("unroll") for (int k = 0; k < 2; ++k) dst[m][k] = *(const PG8_LAS bf16x8*)(lds + PG8_SA(b, h) + aoff + m * 2048 + k * 1024); } while (0)
#define PG8_LDB(dst, b, h) do { _Pragma("unroll") for (int n = 0; n < 2; ++n) _Pragma("unroll") for (int k = 0; k < 2; ++k) dst[n][k] = *(const PG8_LAS bf16x8*)(lds + PG8_SB(b, h) + boff + n * 2048 + k * 1024); } while (0)
#define PG8_MMA(ai, bj, At, Bt) do { __builtin_amdgcn_s_setprio(1); _Pragma("unroll") for (int m = 0; m < 4; ++m) _Pragma("unroll") for (int n = 0; n < 2; ++n) _Pragma("unroll") for (int k = 0; k < 2; ++k) \
        acc[ai][bj][m][n] = __builtin_amdgcn_mfma_f32_16x16x32_bf16(Bt[n][k], At[m][k], acc[ai][bj][m][n], 0, 0, 0); __builtin_amdgcn_s_setprio(0); } while (0)
#define PG8_WAIT_V(n) asm volatile("s_waitcnt vmcnt(" #n ")" ::: "memory")
#define PG8_WAIT_L(n) asm volatile("s_waitcnt lgkmcnt(" #n ")" ::: "memory")
#define PG8_BAR __builtin_amdgcn_s_barrier()
#define PG8_SCHED __builtin_amdgcn_sched_barrier(0)
    Unit cur, nxt; int ui = 0;
    if (!S.next(0, cur)) return;
    f32x4 acc[2][2][4][2];
#pragma unroll
    for (int a = 0; a < 2; ++a)
#pragma unroll
        for (int b = 0; b < 2; ++b)
#pragma unroll
            for (int m = 0; m < 4; ++m)
#pragma unroll
                for (int n = 0; n < 2; ++n) acc[a][b][m][n] = (f32x4){0.f, 0.f, 0.f, 0.f};
    bf16x8 At[4][2], B0[2][2], B1[2][2];
    const char* cA = (const char*)g.A + (size_t)cur.pm * tstep; const char* cB = (const char*)g.Bt + (size_t)cur.pn * tstep;
    S.a_ready(cur);
    if constexpr (SP2) {
        PG8_STAGE(PG8_SB(0, 0), cB, voffB); PG8_STAGE(PG8_SB(0, 1), cB + hstep, voffB); PG8_STAGE(PG8_SA(0, 0), cA, voffA); PG8_STAGE(PG8_SA(0, 1), cA + hstep, voffA);
        if (wr == 1) PG8_BAR;
        PG8_WAIT_V(2); PG8_BAR;
        PG8_STAGE(PG8_SB(1, 0), cB + kstep, voffB); PG8_STAGE(PG8_SA(1, 0), cA + kstep, voffA); PG8_STAGE(PG8_SB(1, 1), cB + hstep + kstep, voffB);
        PG8_WAIT_V(6); PG8_BAR;
    } else {
        PG8_STAGE(PG8_SB(0, 0), cB, voffB); PG8_STAGE(PG8_SA(0, 0), cA, voffA); PG8_STAGE(PG8_SB(0, 1), cB + hstep, voffB); PG8_STAGE(PG8_SA(0, 1), cA + hstep, voffA);
        if (wr == 1) PG8_BAR;
        PG8_WAIT_V(4); PG8_BAR;
        PG8_STAGE(PG8_SB(1, 0), cB + kstep, voffB); PG8_STAGE(PG8_SA(1, 0), cA + kstep, voffA); PG8_STAGE(PG8_SB(1, 1), cB + hstep + kstep, voffB);
        PG8_WAIT_V(6); PG8_BAR;
    }
    for (;;) {
        const bool has_next = S.next(ui + 1, nxt);
        const char* nA = has_next ? (const char*)g.A + (size_t)nxt.pm * tstep : cA; const char* nB = has_next ? (const char*)g.Bt + (size_t)nxt.pn * tstep : cB;
        for (int t = 0; t < nt; t += 2) {
            const bool last = (t == nt - 2);
            const char* a1 = cA + (size_t)(t + 1) * kstep;
            const char* a2 = last ? nA : cA + (size_t)(t + 2) * kstep; const char* b2 = last ? nB : cB + (size_t)(t + 2) * kstep;
            const char* a3 = a2 + kstep; const char* b3 = b2 + kstep;
            if (last && has_next) S.a_ready(nxt);
            if constexpr (SP2) {
            PG8_LDB(B0, 0, 0); PG8_LDB(B1, 0, 1); PG8_SCHED; PG8_LDA(At, 0, 0); PG8_STAGE(PG8_SA(1, 1), a1 + hstep, voffA);
            PG8_WAIT_V(8); PG8_WAIT_L(0); PG8_BAR; PG8_MMA(0, 0, At, B0); PG8_MMA(0, 1, At, B1); PG8_BAR; PG8_SCHED;
            PG8_LDA(At, 0, 1); PG8_STAGE(PG8_SB(0, 0), b2, voffB); PG8_STAGE(PG8_SB(0, 1), b2 + hstep, voffB); PG8_STAGE(PG8_SA(0, 0), a2, voffA);
            PG8_WAIT_V(8); PG8_WAIT_L(0); PG8_BAR; PG8_MMA(1, 0, At, B0); PG8_MMA(1, 1, At, B1); PG8_BAR; PG8_SCHED;
            PG8_LDB(B0, 1, 0); PG8_LDB(B1, 1, 1); PG8_SCHED; PG8_LDA(At, 1, 0); PG8_STAGE(PG8_SA(0, 1), a2 + hstep, voffA);
            PG8_WAIT_V(8); PG8_WAIT_L(0); PG8_BAR; PG8_MMA(0, 0, At, B0); PG8_MMA(0, 1, At, B1); PG8_BAR; PG8_SCHED;
            PG8_LDA(At, 1, 1); PG8_STAGE(PG8_SB(1, 0), b3, voffB); PG8_STAGE(PG8_SB(1, 1), b3 + hstep, voffB); PG8_STAGE(PG8_SA(1, 0), a3, voffA);
            PG8_WAIT_V(8); PG8_WAIT_L(0); PG8_BAR; PG8_MMA(1, 0, At, B0); PG8_MMA(1, 1, At, B1); PG8_BAR; PG8_SCHED;
            } else {
            PG8_LDB(B0, 0, 0); PG8_SCHED; PG8_LDA(At, 0, 0); PG8_STAGE(PG8_SA(1, 1), a1 + hstep, voffA);
            PG8_WAIT_L(8); PG8_BAR; PG8_WAIT_L(0); PG8_MMA(0, 0, At, B0); PG8_BAR; PG8_SCHED;
            PG8_LDB(B1, 0, 1); PG8_STAGE(PG8_SB(0, 0), b2, voffB);
            PG8_BAR; PG8_WAIT_L(0); PG8_MMA(0, 1, At, B1); PG8_BAR;
            PG8_LDA(At, 0, 1); PG8_STAGE(PG8_SA(0, 0), a2, voffA);
            PG8_BAR; PG8_WAIT_L(0); PG8_MMA(1, 0, At, B0); PG8_BAR; PG8_SCHED;
            PG8_STAGE(PG8_SB(0, 1), b2 + hstep, voffB);
            PG8_WAIT_V(6); PG8_BAR; PG8_MMA(1, 1, At, B1); PG8_BAR;
            PG8_LDB(B0, 1, 0); PG8_SCHED; PG8_LDA(At, 1, 0); PG8_STAGE(PG8_SA(0, 1), a2 + hstep, voffA);
            PG8_WAIT_L(8); PG8_BAR; PG8_WAIT_L(0); PG8_MMA(0, 0, At, B0); PG8_BAR; PG8_SCHED;
            PG8_LDB(B1, 1, 1); PG8_STAGE(PG8_SB(1, 0), b3, voffB);
            PG8_BAR; PG8_WAIT_L(0); PG8_MMA(0, 1, At, B1); PG8_BAR;
            PG8_LDA(At, 1, 1); PG8_STAGE(PG8_SA(1, 0), a3, voffA);
            PG8_BAR; PG8_WAIT_L(0); PG8_MMA(1, 0, At, B0); PG8_BAR; PG8_SCHED;
            PG8_STAGE(PG8_SB(1, 1), b3 + hstep, voffB);
            PG8_WAIT_V(6); PG8_BAR; PG8_MMA(1, 1, At, B1); PG8_BAR;
            }
        }
        if constexpr (ALIGN_EPI) { if (wr == 0) PG8_BAR; }
        if constexpr (!Epi::AFTER_DRAIN) { E(acc, cur, wr, wc, fr, fq, lds + STAGE_BYTES, wid, lane); S.done(cur); }
        if (!has_next) break;
#pragma unroll
        for (int a = 0; a < 2; ++a)
#pragma unroll
            for (int b = 0; b < 2; ++b)
#pragma unroll
                for (int m = 0; m < 4; ++m)
#pragma unroll
                    for (int n = 0; n < 2; ++n) acc[a][b][m][n] = (f32x4){0.f, 0.f, 0.f, 0.f};
        cur = nxt; cA = nA; cB = nB; ++ui;
        if constexpr (ALIGN_EPI) { if (wr == 1) PG8_BAR; }
    }
    PG8_WAIT_V(0);
    if constexpr (!ALIGN_EPI) { if (wr == 0) PG8_BAR; }
    PG8_BAR;
    if constexpr (Epi::AFTER_DRAIN) { E.fused(acc, cur, wr, wc, fr, fq, lds, wid, lane); S.done(cur); }
#undef PG8_SA
#undef PG8_SB
#undef PG8_STAGE
#undef PG8_LDA
#undef PG8_LDB
#undef PG8_MMA
#undef PG8_WAIT_V
#undef PG8_WAIT_L
#undef PG8_BAR
#undef PG8_SCHED
}
}
#define LAS __attribute__((address_space(3)))
typedef unsigned short bf16;
typedef unsigned v4u __attribute__((ext_vector_type(4)));
typedef unsigned v2u __attribute__((ext_vector_type(2)));
typedef float f32x4 __attribute__((ext_vector_type(4)));
typedef short bf16x8 __attribute__((ext_vector_type(8)));
typedef short s16x4 __attribute__((ext_vector_type(4)));
constexpr int NWAVES = 8, NTHR = 512;

#define XB_TMO      128
#define XB_XCNT(j)  (256  + 64 * (j))
#define XB_XSUB(j)  (1280 + 64 * (j))
#define XB_XGEN(j)  (2304 + 64 * (j))
#define XB_TOP      3328
#define XB_TOPGEN   3392
#define XCD_BAR_WORDS 3456
#define XB_SPIN_CAP (1u << 18)

__device__ __forceinline__ unsigned xb_ld(unsigned* p)              { return __hip_atomic_load(p, __ATOMIC_RELAXED, __HIP_MEMORY_SCOPE_AGENT); }
__device__ __forceinline__ unsigned xb_add(unsigned* p, unsigned v) { return __hip_atomic_fetch_add(p, v, __ATOMIC_RELAXED, __HIP_MEMORY_SCOPE_AGENT); }
__device__ __forceinline__ unsigned xb_xcc_id() { return (unsigned)__builtin_amdgcn_s_getreg((3 << 11) | 20) & 0xFu; }
#define XB_SPIN(cond, bar) do { unsigned _sp = 0; while (cond) { __builtin_amdgcn_s_sleep(1); \
    if ((++_sp & 255u) == 0u) { if (xb_ld(&(bar)[XB_TMO])) break; if (_sp > XB_SPIN_CAP) { atomicAdd(&(bar)[XB_TMO], 1u); break; } } } } while (0)

struct XcdBarrier {
    unsigned* bar; unsigned x;
    volatile LAS unsigned* st;
};

__device__ __forceinline__ XcdBarrier xcd_barrier_post(unsigned* bar, volatile LAS unsigned* st) {
    XcdBarrier b; b.bar = bar; b.x = xb_xcc_id(); b.st = st;
    if (threadIdx.x == 0) (void)xb_add(&bar[XB_XCNT(b.x)], 1u);
    return b;
}
__device__ __forceinline__ void xcd_barrier_complete(unsigned* bar, unsigned x, unsigned& nloc, unsigned& nx) {
    const unsigned G = gridDim.x * gridDim.y * gridDim.z;
    unsigned sum, cnt, mine, sp = 0u;
    for (;;) {
        sum = 0u; cnt = 0u; mine = 0u;
#pragma unroll
        for (unsigned j = 0; j < 16; ++j) { const unsigned c = xb_ld(&bar[XB_XCNT(j)]); sum += c; cnt += (c > 0u) ? 1u : 0u; mine = (j == x) ? c : mine; }
        if (sum == G) break;
        __builtin_amdgcn_s_sleep(1);
        if ((++sp & 255u) == 0u) { if (xb_ld(&bar[XB_TMO])) break; if (sp > XB_SPIN_CAP) { atomicAdd(&bar[XB_TMO], 1u); break; } }
    }
    nloc = mine > 0u ? mine : 1u; nx = cnt > 0u ? cnt : 1u;
}

__device__ __forceinline__ void xcd_barrier(const XcdBarrier& b) {
    asm volatile("s_waitcnt vmcnt(0)" ::: "memory");
    __syncthreads();
    if (threadIdx.x == 0) {
        unsigned* bar = b.bar;
        __builtin_amdgcn_s_waitcnt(0);
        unsigned nloc = b.st[0], nx = b.st[1];
        if (nloc == 0u) { xcd_barrier_complete(bar, b.x, nloc, nx); b.st[0] = nloc; b.st[1] = nx; }
        const unsigned old = xb_add(&bar[XB_XSUB(b.x)], 1u);
        const unsigned gen = old / nloc;
        if (old + 1u == (gen + 1u) * nloc) {
            __builtin_amdgcn_fence(__ATOMIC_RELEASE, "agent");
            asm volatile("s_waitcnt vmcnt(0)" ::: "memory");
            const unsigned og = xb_add(&bar[XB_TOP], 1u);
            const unsigned tg = og / nx;
            if (og + 1u == (tg + 1u) * nx) xb_add(&bar[XB_TOPGEN], 1u);
            else XB_SPIN(xb_ld(&bar[XB_TOPGEN]) == tg, bar);
            __builtin_amdgcn_fence(__ATOMIC_ACQUIRE, "agent");
            xb_add(&bar[XB_XGEN(b.x)], 1u);
            asm volatile("s_waitcnt vmcnt(0)" ::: "memory");
        } else {
            XB_SPIN(xb_ld(&bar[XB_XGEN(b.x)]) == gen, bar);
            __builtin_amdgcn_fence(__ATOMIC_ACQUIRE, "agent");
            asm volatile("s_waitcnt vmcnt(0)" ::: "memory");
        }
    }
    __syncthreads();
}

__device__ __forceinline__ unsigned pk2(float lo, float hi) { return pg8::cvt_pk_bf16(lo, hi); }
__device__ __forceinline__ float bf_lo(unsigned w) { return __builtin_bit_cast(float, w << 16); }
__device__ __forceinline__ float bf_hi(unsigned w) { return __builtin_bit_cast(float, w & 0xffff0000u); }
__device__ __forceinline__ float wave_sum(float v) {
#pragma unroll
    for (int o = 1; o < 64; o <<= 1) v += __shfl_xor(v, o);
    return v;
}
__device__ __forceinline__ float row16_sum(float v) {
    v += __builtin_bit_cast(float, __builtin_amdgcn_update_dpp(0, __builtin_bit_cast(int, v), 0x128, 0xf, 0xf, false));
    v += __builtin_bit_cast(float, __builtin_amdgcn_update_dpp(0, __builtin_bit_cast(int, v), 0x124, 0xf, 0xf, false));
    v += __builtin_bit_cast(float, __builtin_amdgcn_update_dpp(0, __builtin_bit_cast(int, v), 0x122, 0xf, 0xf, false));
    v += __builtin_bit_cast(float, __builtin_amdgcn_update_dpp(0, __builtin_bit_cast(int, v), 0x121, 0xf, 0xf, false));
    return v;
}
struct Params {
    const float* in[20]; float* out; unsigned char* ws;
};

__device__ __forceinline__ void transpose_item(const float* W, int K, int N, bf16* WT, int mode, LAS float* scr, int item, int lane, const float* kscale = nullptr) {
    const int nblk = N / 32, kb = item / nblk, nb = item % nblk, k0 = 64 * kb, n0 = 32 * nb;
    const int r0 = mode == 0 ? n0 : ((n0 >> 7) * 256 + (n0 & 127) + (mode == 2 ? 128 : 0));
#pragma unroll 8
    for (int i = 0; i < 32; ++i) { const int kk = 2 * i + (lane >> 5); float wv = W[(size_t)(k0 + kk) * N + n0 + (lane & 31)]; if (kscale) wv *= kscale[k0 + kk]; scr[kk * 33 + (lane & 31)] = wv; }
    asm volatile("s_waitcnt lgkmcnt(0)" ::: "memory");
    const int c = lane & 7;
#pragma unroll
    for (int j = 0; j < 4; ++j) { const int n = (lane >> 3) + 8 * j; const LAS float* s = scr + (8 * c) * 33 + n;
        v4u o; o.x = pk2(s[0 * 33], s[1 * 33]); o.y = pk2(s[2 * 33], s[3 * 33]); o.z = pk2(s[4 * 33], s[5 * 33]); o.w = pk2(s[6 * 33], s[7 * 33]);
        *(v4u*)(WT + (size_t)(r0 + n) * K + k0 + 8 * c) = o; }
    asm volatile("s_waitcnt lgkmcnt(0)" ::: "memory");
}

template <int MODE>
__device__ __forceinline__ void row_pass2(const float* xin, bf16* XB, const bf16* Y, const float* wpost, float scale, float* xout, float* R2, int gw, int NGW, int lane) {
    constexpr int RB = 2;
    struct Stage { f32x4 v[RB][4]; v2u xw[RB][4]; v2u yw[RB][4]; };
    Stage st[2];
#define RP_LOAD(S_, m0_) do { _Pragma("unroll") for (int r = 0; r < RB; ++r) { \
            if (MODE <= 1) { const f32x4* xr = (const f32x4*)(xin + (size_t)((m0_) + r) * D_MODEL) + lane; _Pragma("unroll") for (int j = 0; j < 4; ++j) S_.v[r][j] = xr[64 * j]; } \
            else { const v2u* xr = (const v2u*)(XB + (size_t)((m0_) + r) * D_MODEL) + lane; _Pragma("unroll") for (int j = 0; j < 4; ++j) S_.xw[r][j] = xr[64 * j]; } \
            if (MODE >= 1) { const v2u* yr = (const v2u*)(Y + (size_t)((m0_) + r) * D_MODEL) + lane; _Pragma("unroll") for (int j = 0; j < 4; ++j) S_.yw[r][j] = yr[64 * j]; } } } while (0)
#define RP_COMPUTE(S_, m0_) do { _Pragma("unroll") for (int r = 0; r < RB; ++r) { const int m = (m0_) + r; f32x4 v[4]; \
            _Pragma("unroll") for (int j = 0; j < 4; ++j) { if (MODE <= 1) v[j] = S_.v[r][j]; else { const v2u w = S_.xw[r][j]; v[j] = (f32x4){bf_lo(w.x), bf_hi(w.x), bf_lo(w.y), bf_hi(w.y)}; } } \
            if (MODE >= 1) { f32x4 y[4]; float ss = 0.f; \
                _Pragma("unroll") for (int j = 0; j < 4; ++j) { const v2u w = S_.yw[r][j]; y[j] = (f32x4){bf_lo(w.x), bf_hi(w.x), bf_lo(w.y), bf_hi(w.y)}; ss += (y[j].x * y[j].x + y[j].y * y[j].y) + (y[j].z * y[j].z + y[j].w * y[j].w); } \
                const float rr = scale * __builtin_amdgcn_rsqf(wave_sum(ss) * (1.f / D_MODEL) + EPS); \
                _Pragma("unroll") for (int j = 0; j < 4; ++j) { const f32x4 w = ((const f32x4*)wpost)[lane + 64 * j]; v[j] = v[j] + y[j] * w * rr; } } \
            if (MODE == 3) { f32x4* xo = (f32x4*)(xout + (size_t)m * D_MODEL) + lane; _Pragma("unroll") for (int j = 0; j < 4; ++j) __builtin_nontemporal_store(v[j], xo + 64 * j); } \
            else { float ss = 0.f; v2u* o = (v2u*)(XB + (size_t)m * D_MODEL) + lane; \
                _Pragma("unroll") for (int j = 0; j < 4; ++j) { const v2u w = (v2u){pk2(v[j].x, v[j].y), pk2(v[j].z, v[j].w)}; o[64 * j] = w; \
                    const float a = bf_lo(w.x), b2 = bf_hi(w.x), c = bf_lo(w.y), d = bf_hi(w.y); ss += (a * a + b2 * b2) + (c * c + d * d); } \
                ss = wave_sum(ss); if (lane == 0) *(f32x4*)(R2 + (size_t)m * 4) = (f32x4){ss, 0.f, 0.f, 0.f}; } } } while (0)
    const int stride = NGW * RB;
    int m0 = gw * RB;
    if (m0 < MTOK) RP_LOAD(st[0], m0);
    for (; m0 < MTOK; m0 += 2 * stride) {
        if (m0 + stride < MTOK) RP_LOAD(st[1], m0 + stride);
        RP_COMPUTE(st[0], m0);
        if (m0 + stride < MTOK) { if (m0 + 2 * stride < MTOK) RP_LOAD(st[0], m0 + 2 * stride); RP_COMPUTE(st[1], m0 + stride); }
    }
#undef RP_LOAD
#undef RP_COMPUTE
}

__device__ __forceinline__ s16x4 tr_read(const LAS bf16* p) { typedef short v4i16_t __attribute__((ext_vector_type(4))); return __builtin_bit_cast(s16x4, __builtin_amdgcn_ds_read_tr16_b64_v4i16((LAS v4i16_t*)p)); }
__device__ __forceinline__ bf16x8 cat4(s16x4 a, s16x4 b) { return (bf16x8){a[0], a[1], a[2], a[3], b[0], b[1], b[2], b[3]}; }
#define MFMA16(a, b, c) __builtin_amdgcn_mfma_f32_16x16x32_bf16((a), (b), (c), 0, 0, 0)

constexpr int SQ = 136, SV = 72;
struct ScanStage { v4u rq[2], re[2], rkt[2], rv; float rebl; };
__device__ __forceinline__ void scan_phase(LAS unsigned char* lds, unsigned char* ws, int nblk, int bid, int tid) {
    asm volatile("" : "+v"(tid));
    LAS bf16* QT = (LAS bf16*)lds;
    LAS bf16* KTs = QT + 64 * SQ;
    LAS bf16* Vs = KTs + 64 * SQ;
    LAS bf16* Ps = Vs + 64 * SV;
    LAS bf16* Ss = Ps + 64 * SV;
    LAS float* EBLs = (LAS float*)(Ss + 128 * SV);
    const int lane = tid & 63, w = __builtin_amdgcn_readfirstlane(tid >> 6), g = lane >> 4, l15 = lane & 15, q4 = l15 >> 2, p4 = lane & 3;
    const bf16* HQ = (const bf16*)(ws + WS_HQ); const bf16* HV = (const bf16*)(ws + WS_HV);
    for (int item = bid; item < 256; item += nblk) {
        const int vh = item & 1, dir = (item >> 1) & 1, h = (item >> 2) & 3, b = item >> 4;
        const bf16* KT = (const bf16*)(ws + WS_KT) + (size_t)dir * MTOK * 512;
        const bf16* EB = (const bf16*)(ws + WS_EB) + (size_t)dir * MTOK * 512; const float* EBL = (const float*)(ws + WS_EBL) + (size_t)dir * (MTOK / 64) * 512;
        bf16* OD = (bf16*)(ws + WS_Y) + (size_t)dir * MTOK * 512;
        f32x4 sacc[4];
#pragma unroll
        for (int c = 0; c < 4; ++c) sacc[c] = (f32x4){0.f, 0.f, 0.f, 0.f};
        const int prow0 = tid >> 4, pc8 = tid & 15, vrow = tid >> 3, vc8 = tid & 7;
        ScanStage st[2];
#define SCAN_ISSUE(S_, stp) do { const int c_ = dir ? 63 - (stp) : (stp); const size_t rb_ = (size_t)b * SEQ + (size_t)c_ * 64; \
            _Pragma("unroll") for (int i = 0; i < 2; ++i) { const size_t off_ = (rb_ + prow0 + 32 * i) * 512 + h * 128 + 8 * pc8; \
                S_.rq[i] = *(const v4u*)(HQ + off_); S_.re[i] = *(const v4u*)(EB + off_); S_.rkt[i] = *(const v4u*)(KT + off_); } \
            S_.rv = *(const v4u*)(HV + (rb_ + vrow) * 512 + h * 128 + vh * 64 + 8 * vc8); \
            S_.rebl = (tid < 128) ? EBL[((size_t)b * 64 + c_) * 512 + h * 128 + tid] : 0.f; } while (0)
        SCAN_ISSUE(st[0], 0); SCAN_ISSUE(st[1], 1);
        __syncthreads();
#define SCAN_STEP(S_, step) do { \
            const int c = dir ? 63 - (step) : (step); \
              \
            _Pragma("unroll") for (int i = 0; i < 2; ++i) { const int row = prow0 + 32 * i; v4u qt; \
                qt.x = pk2(bf_lo(S_.rq[i].x) * bf_lo(S_.re[i].x), bf_hi(S_.rq[i].x) * bf_hi(S_.re[i].x)); qt.y = pk2(bf_lo(S_.rq[i].y) * bf_lo(S_.re[i].y), bf_hi(S_.rq[i].y) * bf_hi(S_.re[i].y)); \
                qt.z = pk2(bf_lo(S_.rq[i].z) * bf_lo(S_.re[i].z), bf_hi(S_.rq[i].z) * bf_hi(S_.re[i].z)); qt.w = pk2(bf_lo(S_.rq[i].w) * bf_lo(S_.re[i].w), bf_hi(S_.rq[i].w) * bf_hi(S_.re[i].w)); \
                *(LAS v4u*)(QT + row * SQ + 8 * pc8) = qt; *(LAS v4u*)(KTs + row * SQ + 8 * pc8) = S_.rkt[i]; } \
            *(LAS v4u*)(Vs + vrow * SV + 8 * vc8) = S_.rv; \
            if (tid < 128) EBLs[tid] = S_.rebl; \
            _Pragma("unroll") for (int cc = 0; cc < 4; ++cc) *(LAS v2u*)(Ss + (16 * w + l15) * SV + 16 * cc + 4 * g) = (v2u){pk2(sacc[cc][0], sacc[cc][1]), pk2(sacc[cc][2], sacc[cc][3])}; \
            __syncthreads(); \
            if ((step) + 2 < 64) SCAN_ISSUE(S_, (step) + 2); \
              \
            const int si = w >> 1, tj0 = 2 * (w & 1); \
            bf16x8 bq[2][4]; \
            _Pragma("unroll") for (int j = 0; j < 2; ++j) _Pragma("unroll") for (int ks = 0; ks < 4; ++ks) bq[j][ks] = *(const LAS bf16x8*)(QT + (16 * (tj0 + j) + l15) * SQ + 32 * ks + 8 * g); \
            { bf16x8 ak[4]; \
                _Pragma("unroll") for (int ks = 0; ks < 4; ++ks) ak[ks] = *(const LAS bf16x8*)(KTs + (16 * si + l15) * SQ + 32 * ks + 8 * g); \
                _Pragma("unroll") for (int j = 0; j < 2; ++j) { f32x4 d = {0.f, 0.f, 0.f, 0.f}; \
                    _Pragma("unroll") for (int ks = 0; ks < 4; ++ks) d = MFMA16(ak[ks], bq[j][ks], d); \
                    const int t = 16 * (tj0 + j) + l15, s0 = 16 * si + 4 * g; \
                    _Pragma("unroll") for (int r = 0; r < 4; ++r) { const bool keep = dir ? (s0 + r >= t) : (s0 + r <= t); if (!keep) d[r] = 0.f; } \
                    *(LAS v2u*)(Ps + t * SV + s0) = (v2u){pk2(d[0], d[1]), pk2(d[2], d[3])}; } } \
            f32x4 oacc[2]; \
            { bf16x8 as_[4]; \
                _Pragma("unroll") for (int ks = 0; ks < 4; ++ks) { const s16x4 a0 = tr_read(Ss + (32 * ks + 8 * g + q4) * SV + 16 * si + 4 * p4), a1 = tr_read(Ss + (32 * ks + 8 * g + 4 + q4) * SV + 16 * si + 4 * p4); as_[ks] = cat4(a0, a1); } \
                _Pragma("unroll") for (int j = 0; j < 2; ++j) { f32x4 d = {0.f, 0.f, 0.f, 0.f}; \
                    _Pragma("unroll") for (int ks = 0; ks < 4; ++ks) d = MFMA16(as_[ks], bq[j][ks], d); \
                    oacc[j] = d; } } \
            __syncthreads(); \
              \
            { bf16x8 av[2]; \
                _Pragma("unroll") for (int ks = 0; ks < 2; ++ks) { const s16x4 a0 = tr_read(Vs + (32 * ks + 8 * g + q4) * SV + 16 * si + 4 * p4), a1 = tr_read(Vs + (32 * ks + 8 * g + 4 + q4) * SV + 16 * si + 4 * p4); av[ks] = cat4(a0, a1); } \
                _Pragma("unroll") for (int j = 0; j < 2; ++j) { const int t = 16 * (tj0 + j) + l15; \
                    _Pragma("unroll") for (int ks = 0; ks < 2; ++ks) { const bf16x8 bp = *(const LAS bf16x8*)(Ps + t * SV + 32 * ks + 8 * g); oacc[j] = MFMA16(av[ks], bp, oacc[j]); } \
                    *(v2u*)(OD + ((size_t)b * SEQ + (size_t)c * 64 + t) * 512 + h * 128 + vh * 64 + 16 * si + 4 * g) = (v2u){pk2(oacc[j][0], oacc[j][1]), pk2(oacc[j][2], oacc[j][3])}; } } \
            { const float el = EBLs[16 * w + l15]; \
                bf16x8 bk[2]; \
                _Pragma("unroll") for (int ks = 0; ks < 2; ++ks) { const s16x4 a0 = tr_read(KTs + (32 * ks + 8 * g + q4) * SQ + 16 * w + 4 * p4), a1 = tr_read(KTs + (32 * ks + 8 * g + 4 + q4) * SQ + 16 * w + 4 * p4); bk[ks] = cat4(a0, a1); } \
                _Pragma("unroll") for (int cc = 0; cc < 4; ++cc) { \
                    _Pragma("unroll") for (int ks = 0; ks < 2; ++ks) { const s16x4 a0 = tr_read(Vs + (32 * ks + 8 * g + q4) * SV + 16 * cc + 4 * p4), a1 = tr_read(Vs + (32 * ks + 8 * g + 4 + q4) * SV + 16 * cc + 4 * p4); \
                        sacc[cc] = MFMA16(cat4(a0, a1), bk[ks], sacc[cc]); } \
                    sacc[cc] = sacc[cc] * el; } } \
            __syncthreads(); \
        } while (0)
        for (int step = 0; step < 64; step += 2) { SCAN_STEP(st[0], step); SCAN_STEP(st[1], step + 1); }
#undef SCAN_STEP
#undef SCAN_ISSUE
    }
}

constexpr int NKEY = 320, NKEYV = 336, SK = 72;
__device__ __forceinline__ void attn_phase(LAS unsigned char* lds, unsigned char* ws, const float* sink, const float* att_norm, const float* hg_norm, int nblk, int bid, int tid) {
    asm volatile("" : "+v"(tid));
    LAS bf16* Ks = (LAS bf16*)lds;
    LAS bf16* Vs = Ks + NKEY * SK;
    LAS float* SSs = (LAS float*)(Vs + NKEYV * SK);
    const int lane = tid & 63, w = __builtin_amdgcn_readfirstlane(tid >> 6), g = lane >> 4, l15 = lane & 15, q4 = l15 >> 2, p4 = lane & 3;
    const bf16* QB = (const bf16*)(ws + WS_QB); const bf16* KB = (const bf16*)(ws + WS_KB); const bf16* VB = (const bf16*)(ws + WS_VB);
    bf16* CAT = (bf16*)(ws + WS_KK);
    const int hl = w >> 1, rh = w & 1;
    constexpr int NIT = MTOK / 64;
    __syncthreads();
    for (int p = tid; p < 16 * 8; p += NTHR) *(LAS v4u*)(Vs + (NKEY + (p >> 3)) * SK + 8 * (p & 7)) = (v4u){0u, 0u, 0u, 0u};
    v4u kreg[5], vreg[5];
#define ATT_PREFETCH(item_, kvh_) do { const int b_ = (item_) >> 6, q0_ = ((item_) & 63) * 64; const size_t rb_ = (size_t)b_ * SEQ; \
        _Pragma("unroll") for (int i = 0; i < 5; ++i) { const int p = tid + NTHR * i; const int kr = p >> 3, c8 = p & 7; int pos = q0_ - 128 + kr; pos = pos < 0 ? 0 : (pos > SEQ - 1 ? SEQ - 1 : pos); \
            const size_t off = (rb_ + pos) * 128 + (kvh_) * 64 + 8 * c8; kreg[i] = *(const v4u*)(KB + off); vreg[i] = *(const v4u*)(VB + off); } \
        _Pragma("unroll") for (int r2 = 0; r2 < 2; ++r2) _Pragma("unroll") for (int ks = 0; ks < 2; ++ks) bqn[r2][ks] = *(const bf16x8*)(QB + (rb_ + q0_ + 32 * rh + 16 * r2 + l15) * 512 + ((kvh_) * 4 + hl) * 64 + 32 * ks + 8 * g); } while (0)
    bf16x8 bqn[2][2];
    const float sk2a = sink[hl] * LOG2E, sk2b = sink[4 + hl] * LOG2E;
    if (bid < NIT) ATT_PREFETCH(bid, 0);
    for (int item = bid; item < NIT; item += nblk) {
        const int b = item >> 6, q0 = (item & 63) * 64;
        const size_t rbase = (size_t)b * SEQ;
        const bool edge = (q0 < 128) || (q0 + 64 + 128 > SEQ);
#pragma unroll 1
        for (int kvh = 0; kvh < 2; ++kvh) {
            const int head = kvh * 4 + hl;
            bf16x8 bqa[2][2];
#pragma unroll
            for (int r2 = 0; r2 < 2; ++r2) { bqa[r2][0] = bqn[r2][0]; bqa[r2][1] = bqn[r2][1]; }
            __syncthreads();
#pragma unroll
            for (int i = 0; i < 5; ++i) { const int p = tid + NTHR * i; const int kr = p >> 3, c8 = p & 7; *(LAS v4u*)(Ks + kr * SK + 8 * c8) = kreg[i]; *(LAS v4u*)(Vs + kr * SK + 8 * c8) = vreg[i]; }
            __syncthreads();
            asm volatile("" : "+v"(bqa[0][0]), "+v"(bqa[0][1]), "+v"(bqa[1][0]), "+v"(bqa[1][1]));
            { const int nitem = (kvh == 0) ? item : (item + nblk < NIT ? item + nblk : item); const int nkvh = kvh ^ 1; ATT_PREFETCH(nitem, nkvh); }
            const float sk2 = kvh ? sk2b : sk2a;
            if (w >= 4) __builtin_amdgcn_s_sleep(40);
#pragma unroll 1
            for (int rt = 0; rt < 2; ++rt) {
                const int kt0 = 2 * rh + rt; const int rl = 16 * kt0 + l15;
                bf16x8 bq[2];
#pragma unroll
                for (int ks = 0; ks < 2; ++ks) bq[ks] = rt ? bqa[1][ks] : bqa[0][ks];
                const LAS bf16* Kw = Ks + (16 * kt0) * SK; const LAS bf16* Vw = Vs + (16 * kt0) * SK;
                f32x4 s[17];
                {
                    bf16x8 kf[1][4][2];
                    const LAS bf16* Kl = Kw + l15 * SK + 8 * g;
#define ATT_KLOAD(buf, grp) do { _Pragma("unroll") for (int j = 0; j < 4; ++j) { if (4 * (grp) + j < 17) { _Pragma("unroll") for (int ks = 0; ks < 2; ++ks) kf[buf][j][ks] = *(const LAS bf16x8*)(Kl + (16 * (4 * (grp) + j)) * SK + 32 * ks); } } } while (0)
#define ATT_KMMA(buf, grp) do { _Pragma("unroll") for (int j = 0; j < 4; ++j) { if (4 * (grp) + j < 17) { f32x4 d = {0.f, 0.f, 0.f, 0.f}; _Pragma("unroll") for (int ks = 0; ks < 2; ++ks) d = MFMA16(kf[buf][j][ks], bq[ks], d); s[4 * (grp) + j] = d; } } } while (0)
#define ATT_SB() __builtin_amdgcn_sched_barrier(0)
                    ATT_KLOAD(0, 0); ATT_SB(); ATT_KMMA(0, 0); ATT_SB(); ATT_KLOAD(0, 1); ATT_SB(); ATT_KMMA(0, 1); ATT_SB(); ATT_KLOAD(0, 2); ATT_SB(); ATT_KMMA(0, 2); ATT_SB();
                    ATT_KLOAD(0, 3); ATT_SB(); ATT_KMMA(0, 3); ATT_SB(); ATT_KLOAD(0, 4); ATT_SB(); ATT_KMMA(0, 4); ATT_SB();
#undef ATT_KLOAD
#undef ATT_KMMA
                }
#pragma unroll
                for (int r = 0; r < 4; ++r) { if (4 * g + r - l15 < 0) s[0][r] = -1e30f; if (4 * g + r - l15 > 0) s[16][r] = -1e30f; }
                if (edge) {
#pragma unroll
                    for (int i = 0; i < 17; ++i)
#pragma unroll
                        for (int r = 0; r < 4; ++r) { const int kpos = q0 - 128 + 16 * (kt0 + i) + 4 * g + r; if (kpos < 0 || kpos >= SEQ) s[i][r] = -1e30f; } }
                float mx = sk2;
#pragma unroll
                for (int i = 0; i < 17; ++i) mx = fmaxf(fmaxf(mx, fmaxf(s[i][0], s[i][1])), fmaxf(s[i][2], s[i][3]));
                mx = fmaxf(mx, __shfl_xor(mx, 16)); mx = fmaxf(mx, __shfl_xor(mx, 32));
                float sum = 0.f;
#pragma unroll
                for (int i = 0; i < 17; ++i)
#pragma unroll
                    for (int r = 0; r < 4; ++r) { const float pv = __builtin_amdgcn_exp2f(s[i][r] - mx); s[i][r] = pv; sum += pv; }
                sum += __shfl_xor(sum, 16); sum += __shfl_xor(sum, 32);
                const float inv = __builtin_amdgcn_rcpf(sum + __builtin_amdgcn_exp2f(sk2 - mx));
                f32x4 O[4];
#pragma unroll
                for (int dt = 0; dt < 4; ++dt) O[dt] = (f32x4){0.f, 0.f, 0.f, 0.f};
                {
                    s16x4 vfr[1][4][2];
                    const LAS bf16* Vl = Vw + (4 * g + q4) * SK + 4 * p4;
#define ATT_VLOAD(buf, st) do { _Pragma("unroll") for (int dt = 0; dt < 4; ++dt) { vfr[buf][dt][0] = tr_read(Vl + (32 * (st)) * SK + 16 * dt); vfr[buf][dt][1] = tr_read(Vl + (32 * (st) + 16) * SK + 16 * dt); } } while (0)
#define ATT_PV(buf, st) do { v4u pw; pw.x = pk2(s[2 * (st)][0], s[2 * (st)][1]); pw.y = pk2(s[2 * (st)][2], s[2 * (st)][3]); \
                        if ((st) < 8) { pw.z = pk2(s[(st) < 8 ? 2 * (st) + 1 : 0][0], s[(st) < 8 ? 2 * (st) + 1 : 0][1]); pw.w = pk2(s[(st) < 8 ? 2 * (st) + 1 : 0][2], s[(st) < 8 ? 2 * (st) + 1 : 0][3]); } else { pw.z = 0u; pw.w = 0u; } \
                        const bf16x8 bp = __builtin_bit_cast(bf16x8, pw); \
                        _Pragma("unroll") for (int dt = 0; dt < 4; ++dt) O[dt] = MFMA16(cat4(vfr[buf][dt][0], vfr[buf][dt][1]), bp, O[dt]); } while (0)
                    ATT_VLOAD(0, 0); ATT_SB(); ATT_PV(0, 0); ATT_SB();
                    ATT_VLOAD(0, 1); ATT_SB(); ATT_PV(0, 1); ATT_SB();
                    ATT_VLOAD(0, 2); ATT_SB(); ATT_PV(0, 2); ATT_SB();
                    ATT_VLOAD(0, 3); ATT_SB(); ATT_PV(0, 3); ATT_SB();
                    ATT_VLOAD(0, 4); ATT_SB(); ATT_PV(0, 4); ATT_SB();
                    ATT_VLOAD(0, 5); ATT_SB(); ATT_PV(0, 5); ATT_SB();
                    ATT_VLOAD(0, 6); ATT_SB(); ATT_PV(0, 6); ATT_SB();
                    ATT_VLOAD(0, 7); ATT_SB(); ATT_PV(0, 7); ATT_SB();
                    ATT_VLOAD(0, 8); ATT_SB(); ATT_PV(0, 8); ATT_SB();
#undef ATT_VLOAD
#undef ATT_PV
#undef ATT_SB
                }
                float ssq = 0.f;
#pragma unroll
                for (int dt = 0; dt < 4; ++dt) { O[dt] = O[dt] * inv;
                    const v2u ow = (v2u){pk2(O[dt][0], O[dt][1]), pk2(O[dt][2], O[dt][3])};
                    *(v2u*)(CAT + (rbase + q0 + rl) * 1024 + head * 64 + 16 * dt + 4 * g) = ow;
                    const float a = bf_lo(ow.x), b2 = bf_hi(ow.x), c = bf_lo(ow.y), d = bf_hi(ow.y); ssq += (a * a + b2 * b2) + (c * c + d * d); }
                ssq += __shfl_xor(ssq, 16); ssq += __shfl_xor(ssq, 32);
                if (g == 0) SSs[rl * 8 + head] = ssq;
            }
        }
        asm volatile("s_waitcnt vmcnt(0)" ::: "memory");
        __syncthreads();
        { const bf16* OF = (const bf16*)(ws + WS_Y); const bf16* OBk = OF + (size_t)MTOK * 512; const bf16* HG = (const bf16*)(ws + WS_HG);
            const f32x4 w0 = *(const f32x4*)(hg_norm + 8 * l15), w1 = *(const f32x4*)(hg_norm + 8 * l15 + 4);
            const f32x4 n0 = *(const f32x4*)(att_norm + 8 * lane), n1 = *(const f32x4*)(att_norm + 8 * lane + 4);
            v4u la[8], lb[8], lg[8], lc[8];
#pragma unroll
            for (int i = 0; i < 8; ++i) { const size_t row = rbase + q0 + 8 * w + i; const size_t off = row * 512 + 8 * lane;
                la[i] = *(const v4u*)(OF + off); lb[i] = *(const v4u*)(OBk + off); lg[i] = *(const v4u*)(HG + off); lc[i] = *(const v4u*)(CAT + row * 1024 + 8 * lane); }
#pragma unroll
            for (int i = 0; i < 8; ++i) { const int rl = 8 * w + i; const size_t row = rbase + q0 + rl;
                const v4u a = la[i], bb = lb[i], gg = lg[i], ar = lc[i];
                const LAS f32x4* sp = (const LAS f32x4*)(SSs + rl * 8); const f32x4 t0 = sp[0], t1 = sp[1];
                const float rna = __builtin_amdgcn_rsqf((((t0[0] + t0[1]) + (t0[2] + t0[3])) + ((t1[0] + t1[1]) + (t1[2] + t1[3]))) * (1.f / 512.f) + EPS);
                v4u ao; ao.x = pk2(bf_lo(ar.x) * rna * n0[0], bf_hi(ar.x) * rna * n0[1]); ao.y = pk2(bf_lo(ar.y) * rna * n0[2], bf_hi(ar.y) * rna * n0[3]);
                ao.z = pk2(bf_lo(ar.z) * rna * n1[0], bf_hi(ar.z) * rna * n1[1]); ao.w = pk2(bf_lo(ar.w) * rna * n1[2], bf_hi(ar.w) * rna * n1[3]);
                *(v4u*)(CAT + row * 1024 + 8 * lane) = ao;
                float v[8]; v[0] = bf_lo(a.x) + bf_lo(bb.x); v[1] = bf_hi(a.x) + bf_hi(bb.x); v[2] = bf_lo(a.y) + bf_lo(bb.y); v[3] = bf_hi(a.y) + bf_hi(bb.y);
                v[4] = bf_lo(a.z) + bf_lo(bb.z); v[5] = bf_hi(a.z) + bf_hi(bb.z); v[6] = bf_lo(a.w) + bf_lo(bb.w); v[7] = bf_hi(a.w) + bf_hi(bb.w);
                float ss = 0.f;
#pragma unroll
                for (int e2 = 0; e2 < 8; ++e2) ss += v[e2] * v[e2];
                ss = row16_sum(ss);
                const float rn = __builtin_amdgcn_rsqf(ss * (1.f / 128.f) + EPS);
                v4u o; o.x = pk2(v[0] * rn * w0[0] * bf_lo(gg.x), v[1] * rn * w0[1] * bf_hi(gg.x)); o.y = pk2(v[2] * rn * w0[2] * bf_lo(gg.y), v[3] * rn * w0[3] * bf_hi(gg.y));
                o.z = pk2(v[4] * rn * w1[0] * bf_lo(gg.z), v[5] * rn * w1[1] * bf_hi(gg.z)); o.w = pk2(v[6] * rn * w1[2] * bf_lo(gg.w), v[7] * rn * w1[3] * bf_hi(gg.w));
                *(v4u*)(CAT + row * 1024 + 512 + 8 * lane) = o; } }
    }
#undef ATT_PREFETCH
}

__global__ void __launch_bounds__(NTHR, 2) fwd_mega(Params P) {
    extern __shared__ __attribute__((aligned(16))) unsigned char lds_raw[];
    cg::grid_group grid = cg::this_grid();
    LAS unsigned char* lds = (LAS unsigned char*)lds_raw;
    const int tid = threadIdx.x, lane = tid & 63, wave = __builtin_amdgcn_readfirstlane(tid >> 6);
    volatile LAS unsigned* MISC = (volatile LAS unsigned*)(lds + 131072 + 8192);
    if (tid < 16) MISC[tid] = 0u;
    __syncthreads();
    XcdBarrier xbar = xcd_barrier_post((unsigned*)P.ws, MISC + 8);
#define FAST_SYNC() xcd_barrier(xbar)
    const int G = gridDim.x, bid = blockIdx.x;
    const int gw = bid * NWAVES + wave, NGW = G * NWAVES;
    unsigned char* ws = P.ws;
    const float* x = P.in[0];
    bf16* XN = (bf16*)(ws + WS_XN); bf16* Y = (bf16*)(ws + WS_Y); bf16* H = (bf16*)(ws + WS_H);
    float* rope = (float*)(ws + WS_ROPE); float* R2 = (float*)(ws + WS_SS2); unsigned* CNT = (unsigned*)ws; float* XB = (float*)(ws + WS_XB);
    bf16* XN2 = (bf16*)(ws + WS_Y);

    constexpr int I_GU = (D_MODEL / 64) * (D_FF / 32), I_D = (D_FF / 64) * (D_MODEL / 32), I_IN = (D_MODEL / 64) * (IN_WIDTH / 32), I_OUT = (D_MODEL / 64) * (D_MODEL / 32);
    constexpr int NITEMS = 4 * I_GU + 2 * I_D + I_IN + I_OUT;
    LAS float* scr = (LAS float*)(lds + wave * 16384);
    {
#define TRANSPOSE_RANGE(lo_, hi_) do { for (int it = (lo_) + gw; it < (hi_); it += NGW) { int r = it; \
            if (r < I_GU) { transpose_item(P.in[3], D_MODEL, D_FF, (bf16*)(ws + WS_W1GU), 1, scr, r, lane, P.in[1]); continue; } r -= I_GU; \
            if (r < I_GU) { transpose_item(P.in[4], D_MODEL, D_FF, (bf16*)(ws + WS_W1GU), 2, scr, r, lane, P.in[1]); continue; } r -= I_GU; \
            if (r < I_D) { transpose_item(P.in[5], D_FF, D_MODEL, (bf16*)(ws + WS_W1D), 0, scr, r, lane); continue; } r -= I_D; \
            if (r < I_IN) { transpose_item(P.in[8], D_MODEL, IN_WIDTH, (bf16*)(ws + WS_WIN), 0, scr, r, lane, P.in[6]); continue; } r -= I_IN; \
            if (r < I_OUT) { transpose_item(P.in[14], D_MODEL, D_MODEL, (bf16*)(ws + WS_WOUT), 0, scr, r, lane); continue; } r -= I_OUT; \
            if (r < I_GU) { transpose_item(P.in[17], D_MODEL, D_FF, (bf16*)(ws + WS_W2GU), 1, scr, r, lane, P.in[15]); continue; } r -= I_GU; \
            if (r < I_GU) { transpose_item(P.in[18], D_MODEL, D_FF, (bf16*)(ws + WS_W2GU), 2, scr, r, lane, P.in[15]); continue; } r -= I_GU; \
            transpose_item(P.in[19], D_FF, D_MODEL, (bf16*)(ws + WS_W2D), 0, scr, r, lane); } } while (0)
        if (wave < 4) TRANSPOSE_RANGE(0, NITEMS);
        for (int i = bid * NTHR + tid; i < SEQ * 8; i += G * NTHR) { const int pos = i >> 3, j = i & 7;
            const double th = j == 0 ? 1.0 : j == 1 ? 0.19392274474868576 : j == 2 ? 0.03760603093086393 : j == 3 ? 0.007292664737217109 : j == 4 ? 0.001414213562373095 : j == 5 ? 0.0002742481756762073 : j == 6 ? 5.318295896944988e-05 : 1.031338537721246e-05;
            const double ang = (double)pos * th; const double nn = __builtin_rint(ang * 0.15915494309189535); const double r = __builtin_fma(-nn, 2.4492935982947064e-16, __builtin_fma(-nn, 6.283185307179586, ang)); const double r2 = r * r;
            double sn = 1.0, cs = 1.0;
            for (int k = 15; k >= 1; --k) { sn = 1.0 - r2 * sn / (double)((2 * k) * (2 * k + 1)); cs = 1.0 - r2 * cs / (double)((2 * k - 1) * (2 * k)); }
            rope[pos * 16 + j] = (float)cs; rope[pos * 16 + 8 + j] = (float)(r * sn); }
        row_pass2<0>(x, XN, nullptr, nullptr, 0.f, nullptr, R2, gw, NGW, lane);
        if (wave >= 4) TRANSPOSE_RANGE(0, NITEMS);
    }
    if (P.ws == nullptr) grid.sync();
    FAST_SYNC();
    if (tid == 0) *(volatile LAS int*)(lds + 131072 + 4096 + 1024) = -1;
    __syncthreads();
    { pg8::Gemm g{XN, (const bf16*)(ws + WS_W1GU), MTOK, 2 * D_FF, D_MODEL}; pg8::StaticOrder S; S.init(MTOK, 2 * D_FF, G, bid); pg8::EpiSwiGLU E{H, D_FF, R2};
      pg8::gemm_phase<pg8::EpiSwiGLU, pg8::StaticOrder, true, true>(lds, g, S, E);
#ifdef DUP_P1
      __syncthreads(); pg8::gemm_phase<pg8::EpiSwiGLU, pg8::StaticOrder, true, true>(lds, g, S, E);
#endif
    }
    FAST_SYNC();
    { pg8::Gemm g{H, (const bf16*)(ws + WS_W1D), MTOK, D_MODEL, D_FF}; pg8::StaticOrder S; S.init(MTOK, D_MODEL, G, bid);
      pg8::EpiNormRes2 E{XN, nullptr, P.in[2], 0.5f, XB, CNT + 4096, R2};
      pg8::gemm_phase<pg8::EpiNormRes2, pg8::StaticOrder, true, true>(lds, g, S, E); }
    FAST_SYNC();
    if (tid == 0) *(volatile LAS int*)(lds + 131072 + 4096 + 1024) = -1;
    __syncthreads();
    { pg8::Gemm g{XN, (const bf16*)(ws + WS_WIN), MTOK, IN_WIDTH, D_MODEL}; pg8::StaticOrder S; S.init(MTOK, IN_WIDTH, G, bid);
      pg8::EpiMixer E{ws, R2, P.in[11], P.in[12]};
#ifndef NO_MIX
      { LAS float* lbt = (LAS float*)(lds + 131072);
        for (int i = tid; i < 1024; i += NTHR) { const float* lr = (i >> 9) ? P.in[12] : P.in[11]; const int cidx = i & 511; lbt[i] = __builtin_amdgcn_rcpf(1.0f + __expf(lr[512 + cidx] - lr[cidx])); }
        __syncthreads(); }
      pg8::gemm_phase<pg8::EpiMixer, pg8::StaticOrder, true, true>(lds, g, S, E);
#ifdef DUP_P4
      __syncthreads(); pg8::gemm_phase<pg8::EpiMixer, pg8::StaticOrder, true, true>(lds, g, S, E);
#endif
#endif
    }
    FAST_SYNC();
#ifndef NO_SCAN
    scan_phase(lds, ws, G, bid, tid);
#ifdef DUP_SCAN
    __syncthreads(); scan_phase(lds, ws, G, bid, tid);
#endif
#endif
    FAST_SYNC();
#ifndef NO_ATTN
    attn_phase(lds, ws, P.in[9], P.in[10], P.in[13], G, bid, tid);
#ifdef DUP_ATTN
    __syncthreads(); attn_phase(lds, ws, P.in[9], P.in[10], P.in[13], G, bid, tid);
#endif
#endif
    FAST_SYNC();
    { pg8::Gemm g{(const bf16*)(ws + WS_KK), (const bf16*)(ws + WS_WOUT), MTOK, D_MODEL, D_MODEL}; pg8::StaticOrder S; S.init(MTOK, D_MODEL, G, bid);
      pg8::EpiNormRes2 E{XN, nullptr, P.in[7], 1.0f, XB + (size_t)MTOK * 4, CNT + 4096 + 256 * 64, R2};
      pg8::gemm_phase<pg8::EpiNormRes2, pg8::StaticOrder, true, true>(lds, g, S, E); }
    FAST_SYNC();
    if (tid == 0) *(volatile LAS int*)(lds + 131072 + 4096 + 1024) = -1;
    __syncthreads();
    { pg8::Gemm g{XN, (const bf16*)(ws + WS_W2GU), MTOK, 2 * D_FF, D_MODEL}; pg8::StaticOrder S; S.init(MTOK, 2 * D_FF, G, bid); pg8::EpiSwiGLU E{H, D_FF, R2};
      pg8::gemm_phase<pg8::EpiSwiGLU, pg8::StaticOrder, true, true>(lds, g, S, E); }
    FAST_SYNC();
    { pg8::Gemm g{H, (const bf16*)(ws + WS_W2D), MTOK, D_MODEL, D_FF}; pg8::StaticOrder S; S.init(MTOK, D_MODEL, G, bid);
      pg8::EpiNormRes2 E{XN, P.out, P.in[16], 0.5f, XB + (size_t)2 * MTOK * 4, CNT + 4096 + 2 * 256 * 64, R2};
      pg8::gemm_phase<pg8::EpiNormRes2, pg8::StaticOrder, true, true>(lds, g, S, E); }
}

extern "C" void kernel_launch(void* const* d_in, const int* in_sizes, int n_in, void* d_out, int out_size, void* d_ws, size_t ws_size, hipStream_t stream) {
    static int grid = 0;
    if (grid == 0) {
        if (n_in != 20 || ws_size < WS_END) { fprintf(stderr, "kernel_launch: unexpected n_in %d / ws %zu\n", n_in, ws_size); grid = -1; return; }
        int dev = 0, cus = 0, per_cu = 0;
        hipGetDevice(&dev); hipDeviceGetAttribute(&cus, hipDeviceAttributeMultiprocessorCount, dev);
        hipFuncSetAttribute((const void*)fwd_mega, hipFuncAttributeMaxDynamicSharedMemorySize, LDS_BYTES);
        hipOccupancyMaxActiveBlocksPerMultiprocessor(&per_cu, (const void*)fwd_mega, NTHR, LDS_BYTES);
        if (per_cu < 1) { fprintf(stderr, "kernel_launch: occupancy query gave %d\n", per_cu); per_cu = 1; }
        grid = cus * 1;
        (void)hipGetLastError();
    }
    if (grid < 0) return;
    if (hipMemsetAsync(d_ws, 0, CTL_BYTES, stream) != hipSuccess) { fprintf(stderr, "memset failed\n"); return; }
    if (hipMemsetAsync((unsigned char*)d_ws + WS_XB, 0xFF, (size_t)3 * MTOK * 4 * sizeof(float), stream) != hipSuccess) { fprintf(stderr, "memset 2 failed\n"); return; }
    Params p{};
    for (int i = 0; i < 20; ++i) p.in[i] = (const float*)d_in[i];
    p.out = (float*)d_out; p.ws = (unsigned char*)d_ws;
    void* args[] = {&p};
    hipError_t e = hipLaunchCooperativeKernel((const void*)fwd_mega, dim3(grid), dim3(NTHR), args, LDS_BYTES, stream);
    if (e != hipSuccess) fprintf(stderr, "cooperative launch failed: %s (grid %d)\n", hipGetErrorString(e), grid);
}
```

```cpp
#include <hip/hip_runtime.h>
#include <hip/hip_cooperative_groups.h>
#include <cstdio>
#include <cstdint>
namespace cg = cooperative_groups;

constexpr int D_MODEL = 1024, BATCH = 16, SEQ = 4096, MTOK = BATCH * SEQ;
constexpr int D_FF = 2816, IN_WIDTH = 3328;
constexpr float EPS = 1e-6f;
constexpr float LOG2E = 1.4426950408889634f;
constexpr float QSCALE = 0.125f * LOG2E;

constexpr size_t MiB = 1u << 20;
constexpr size_t WS_ROPE = 1 * MiB;
constexpr size_t WS_W1GU = 2 * MiB, WS_W1D = 13 * MiB, WS_WIN = 19 * MiB, WS_WOUT = 26 * MiB, WS_W2GU = 28 * MiB, WS_W2D = 39 * MiB;
constexpr size_t WS_XN = 48 * MiB;
constexpr size_t WS_Y = 176 * MiB;
constexpr size_t WS_H = 304 * MiB;
constexpr size_t WS_QB = 304 * MiB, WS_KB = 368 * MiB, WS_VB = 384 * MiB, WS_HQ = 400 * MiB, WS_HV = 464 * MiB, WS_HG = 528 * MiB;
constexpr size_t WS_KT = 592 * MiB, WS_KK = 720 * MiB, WS_EB = 848 * MiB;
constexpr size_t WS_EBL = 976 * MiB;
constexpr size_t WS_XB = 980 * MiB;
constexpr size_t WS_SS2 = 984 * MiB;
constexpr size_t WS_END = 985 * MiB;
constexpr size_t CTL_BYTES = 262144;
constexpr int LDS_BYTES = 147456;

namespace pg8 {
#define PG8_LAS __attribute__((address_space(3)))
typedef unsigned short bf16_t;
typedef short bf16x8 __attribute__((ext_vector_type(8)));
typedef float f32x4 __attribute__((ext_vector_type(4)));
typedef unsigned u32x4 __attribute__((ext_vector_type(4)));
constexpr int BM = 256, BK = 64, HALF = 128, HTB = HALF * BK * 2  , STAGE_BYTES = 8 * HTB, NXCD = 8, WGM = 8;

__host__ __device__ __forceinline__ int lds_byte(int r, int c) { const int st = (r >> 4) * 2 + (c >> 5), rr = r & 15, cc = c & 31, ob = rr * 64 + cc * 2; return st * 1024 + (ob ^ (((ob >> 9) & 1) << 5)); }
__host__ __device__ __forceinline__ void stage_rc(int b, int& R, int& C) { const int st = b / 1024, sb = b % 1024, swz = sb ^ (((sb >> 9) & 1) << 5); R = (st >> 1) * 16 + swz / 64; C = (st & 1) * 32 + (swz % 64) / 2; }
__host__ __device__ __forceinline__ int perm32(int rho) { const int n = rho >> 4, i = rho & 15; return 8 * (i >> 2) + 4 * n + (i & 3); }

struct Unit { int pm, pn; };
struct Gemm { const bf16_t* A; const bf16_t* Bt; int M, N, K; };

struct StaticOrder {
    int nM, nN, nwg, G, c;
    __host__ __device__ void init(int M, int N, int G_, int c_) { nM = M / BM; nN = N / BM; nwg = nM * nN; G = G_; c = c_; }
    __host__ __device__ bool next(int i, Unit& u) const {
        const long L = (long)i * G + c; if (L >= nwg) return false;
        int wgid = (int)L; { const int q = nwg / NXCD, r = nwg % NXCD, xcd = wgid % NXCD, off = wgid / NXCD; wgid = (xcd < r ? xcd * (q + 1) : r * (q + 1) + (xcd - r) * q) + off; }
        const int nig = WGM * nN, gid = wgid / nig, fm = gid * WGM, gsz = (nM - fm) < WGM ? (nM - fm) : WGM;
        u.pm = fm + ((wgid % nig) % gsz); u.pn = (wgid % nig) / gsz; return true;
    }
    __device__ __forceinline__ void a_ready(const Unit&) const {}
    __device__ __forceinline__ void done(const Unit&) const {}
};
typedef unsigned u32x2 __attribute__((ext_vector_type(2)));
typedef float f32x2_t __attribute__((ext_vector_type(2))); typedef __bf16 bf16x2_t __attribute__((ext_vector_type(2)));
__device__ __forceinline__ unsigned cvt_pk_bf16(float lo, float hi) { f32x2_t v = {lo, hi}; bf16x2_t b = __builtin_convertvector(v, bf16x2_t); return __builtin_bit_cast(unsigned, b); }
__device__ __forceinline__ void store8(bf16_t* p, const f32x4 v0, const f32x4 v1) {
    u32x4 w; w.x = cvt_pk_bf16(v0[0], v0[1]); w.y = cvt_pk_bf16(v0[2], v0[3]); w.z = cvt_pk_bf16(v1[0], v1[1]); w.w = cvt_pk_bf16(v1[2], v1[3]); *(u32x4*)p = w; }
__device__ __forceinline__ void store4(bf16_t* p, const f32x4 v0) { u32x2 w; w.x = cvt_pk_bf16(v0[0], v0[1]); w.y = cvt_pk_bf16(v0[2], v0[3]); *(u32x2*)p = w; }
__device__ __forceinline__ float fsigmoid(float x) { return __builtin_amdgcn_rcpf(1.0f + __builtin_amdgcn_exp2f(-1.4426950408889634f * x)); }
__device__ __forceinline__ f32x4 sigmoid4(f32x4 v) { return (f32x4){fsigmoid(v[0]), fsigmoid(v[1]), fsigmoid(v[2]), fsigmoid(v[3])}; }

__device__ __forceinline__ float row_rs(const float* ss4, int row) { const f32x4 p = *(const f32x4*)(ss4 + (unsigned)(row * 4)); return __builtin_amdgcn_rsqf(((p[0] + p[1]) + (p[2] + p[3])) * (1.0f / 1024.0f) + 1e-6f); }
__device__ __forceinline__ const PG8_LAS float* row_scale_table(const float* ss4, int pm, PG8_LAS unsigned char* ldse, int wid, int lane) {
    PG8_LAS float* rst = (PG8_LAS float*)(ldse + 4096); volatile PG8_LAS int* tag = (volatile PG8_LAS int*)(ldse + 4096 + 1024);
    if (*tag != pm) {
        const int t_ = wid * 64 + lane; if (t_ < 256) rst[t_] = row_rs(ss4, pm * BM + t_);
        asm volatile("s_waitcnt lgkmcnt(0)" ::: "memory"); __builtin_amdgcn_s_barrier(); asm volatile("" ::: "memory");
        if (t_ == 0) *tag = pm;
    }
    return rst;
}
struct EpiPlain {
    static constexpr bool PERM = true, AFTER_DRAIN = false;
    bf16_t* O; int ldc;
    __device__ __forceinline__ void operator()(const f32x4 (&acc)[2][2][4][2], const Unit& u, int wr, int wc, int fr, int fq, PG8_LAS unsigned char*, int, int) const {
        const int row0 = u.pm * BM + wr * 64 + fr, col0 = u.pn * BM + wc * 32 + 8 * fq;
#pragma unroll
        for (int ai = 0; ai < 2; ++ai)
#pragma unroll
            for (int m = 0; m < 4; ++m) { bf16_t* rowp = O + (size_t)(row0 + ai * HALF + m * 16) * ldc + col0;
#pragma unroll
                for (int bj = 0; bj < 2; ++bj) store8(rowp + bj * HALF, acc[ai][bj][m][0], acc[ai][bj][m][1]); }
    }
};
struct EpiSwiGLU {
    static constexpr bool PERM = true, AFTER_DRAIN = false;
    bf16_t* H; int ldh; const float* ss2;
    __device__ __forceinline__ void operator()(const f32x4 (&acc)[2][2][4][2], const Unit& u, int wr, int wc, int fr, int fq, PG8_LAS unsigned char* ldse, int wid, int lane_) const {
        const int row0 = u.pm * BM + wr * 64 + fr, col0 = u.pn * HALF + wc * 32 + 8 * fq;
        const PG8_LAS float* rsl = row_scale_table(ss2, u.pm, ldse, wid, lane_) + wr * 64 + fr;
#pragma unroll
        for (int ai = 0; ai < 2; ++ai)
#pragma unroll
            for (int m = 0; m < 4; ++m) { bf16_t* rowp = H + (size_t)(row0 + ai * HALF + m * 16) * ldh + col0;
                const float rs = rsl[ai * HALF + m * 16];
                const f32x4 g0 = acc[ai][0][m][0] * rs, g1 = acc[ai][0][m][1] * rs, u0 = acc[ai][1][m][0] * rs, u1 = acc[ai][1][m][1] * rs;
                store8(rowp, g0 * sigmoid4(g0) * u0, g1 * sigmoid4(g1) * u1); }
    }
};
struct EpiMixer {
    static constexpr bool PERM = true, AFTER_DRAIN = false;
    unsigned char* ws; const float* ss2;
    const float *lbf, *lbb;
    __device__ __forceinline__ void operator()(const f32x4 (&acc)[2][2][4][2], const Unit& u, int wr, int wc, int fr, int fq, PG8_LAS unsigned char* ldse, int wid, int lane_) const {
        const int pn = u.pn; const int row0 = u.pm * BM + wr * 64 + fr; const int cl0 = wc * 32 + 8 * fq;
        const PG8_LAS float* rsl = row_scale_table(ss2, u.pm, ldse, wid, lane_) + wr * 64 + fr;
        bf16_t* const QB = (bf16_t*)(ws + WS_QB); bf16_t* const KB = (bf16_t*)(ws + WS_KB); bf16_t* const VB = (bf16_t*)(ws + WS_VB); bf16_t* const HQ = (bf16_t*)(ws + WS_HQ);
        bf16_t* const HV = (bf16_t*)(ws + WS_HV); bf16_t* const HG = (bf16_t*)(ws + WS_HG); const float* const rope = (const float*)(ws + WS_ROPE);
        if (pn <= 2) {
#ifndef NO_B1
            float rsa[2][4];
#pragma unroll
            for (int ai = 0; ai < 2; ++ai)
#pragma unroll
                for (int m = 0; m < 4; ++m) rsa[ai][m] = rsl[ai * HALF + m * 16];
            const bool rotw = (wc & 1) == 0;
#pragma unroll
            for (int ai = 0; ai < 2; ++ai)
#pragma unroll
                for (int m = 0; m < 4; ++m) { const int row = row0 + ai * HALF + m * 16; const int pos = row & (SEQ - 1); const float rsr = rsa[ai][m];
                    f32x4 c0 = {1.f, 1.f, 1.f, 1.f}, c1 = c0, s0 = {0.f, 0.f, 0.f, 0.f}, s1 = s0;
                    if (rotw && fq < 2) { const f32x4* rp = (const f32x4*)(rope + pos * 16); c0 = rp[0]; c1 = rp[1]; s0 = rp[2]; s1 = rp[3]; if (fq == 0) { s0 = -s0; s1 = -s1; } }
#pragma unroll
                    for (int bj = 0; bj < 2; ++bj) { f32x4 v0 = acc[ai][bj][m][0] * rsr, v1 = acc[ai][bj][m][1] * rsr;
                        const bool dorot = rotw && !(pn == 2 && bj == 1);
                        if (dorot) { f32x4 p0, p1;
#pragma unroll
                            for (int i = 0; i < 4; ++i) { p0[i] = __shfl_xor(v0[i], 16); p1[i] = __shfl_xor(v1[i], 16); }
                            v0 = v0 * c0 + p0 * s0; v1 = v1 * c1 + p1 * s1; }
                        if (pn < 2) { v0 = v0 * QSCALE; v1 = v1 * QSCALE; store8(QB + (size_t)row * 512 + pn * 256 + bj * HALF + cl0, v0, v1); }
                        else if (bj == 0) store8(KB + (size_t)row * 128 + cl0, v0, v1);
                        else store8(VB + (size_t)row * 128 + cl0, v0, v1); }
                    if (m & 1) asm volatile("" ::: "memory"); }
#endif
        } else if (pn <= 4 || pn >= 9) {
#ifndef NO_B2
        float rsa[2][4];
#pragma unroll
        for (int ai = 0; ai < 2; ++ai)
#pragma unroll
            for (int m = 0; m < 4; ++m) rsa[ai][m] = rsl[ai * HALF + m * 16];
            bf16_t* dst = pn <= 4 ? HQ : (pn <= 10 ? HV : HG); const int cb = (pn <= 4 ? pn - 3 : (pn <= 10 ? pn - 9 : pn - 11)) * 256 + cl0; const bool mulx = pn >= 9;
#pragma unroll
            for (int ai = 0; ai < 2; ++ai)
#pragma unroll
                for (int m = 0; m < 4; ++m) { const int row = row0 + ai * HALF + m * 16; const float rsr = rsa[ai][m];
#pragma unroll
                    for (int bj = 0; bj < 2; ++bj) { f32x4 v0 = acc[ai][bj][m][0] * rsr, v1 = acc[ai][bj][m][1] * rsr; f32x4 a0 = sigmoid4(v0), a1 = sigmoid4(v1);
                        if (mulx) { a0 = a0 * v0; a1 = a1 * v1; }
                        store8(dst + (size_t)row * 512 + cb + bj * HALF, a0, a1); }
                    asm volatile("" ::: "memory"); }
#endif
        } else {
#ifndef NO_B3
            const int dir = (pn - 5) >> 1; const int cb = ((pn - 5) & 1) * 256 + cl0; const float* lbr = dir ? lbb : lbf;
            const size_t dstride = (size_t)MTOK * 512; bf16_t* kt = (bf16_t*)(ws + WS_KT) + dir * dstride; bf16_t* eb = (bf16_t*)(ws + WS_EB) + dir * dstride; float* ebl = (float*)(ws + WS_EBL) + (size_t)dir * (MTOK / 64) * 512;
            const int lane = fq * 16 + fr;
#pragma unroll
            for (int ai = 0; ai < 2; ++ai)
#pragma unroll
                for (int bj = 0; bj < 2; ++bj) { const int colg = cb + bj * HALF;
                  u32x4 ebp[4], ktp[4]; f32x4 eTa, eTb;
                  float rsr[4];
#pragma unroll
                  for (int m = 0; m < 4; ++m) rsr[m] = rsl[ai * HALF + m * 16];
#pragma unroll
                  for (int nh = 0; nh < 4; ++nh) { const int n = nh >> 1, eh = (nh & 1) * 2; const int col = colg + 4 * n + eh;
                    float lb[2];
#pragma unroll
                    for (int e = 0; e < 2; ++e) lb[e] = ((const PG8_LAS float*)ldse)[dir * 512 + col + e];
                    float G[4][2], KC[4][2];
#pragma unroll
                    for (int m = 0; m < 4; ++m) {
#pragma unroll
                        for (int e = 0; e < 2; ++e) { float x = acc[ai][bj][m][n][eh + e] * rsr[m]; asm volatile("" : "+v"(x)); const float f = lb[e] + (1.0f - lb[e]) * fsigmoid(x); G[m][e] = __builtin_amdgcn_logf(f); KC[m][e] = 1.0f - f; } }
                    float T[2];
#pragma unroll
                    for (int e = 0; e < 2; ++e) { float tot = 0.f;
#pragma unroll
                        for (int m = 0; m < 4; ++m) { float v = G[m][e];
                            v += __builtin_bit_cast(float, __builtin_amdgcn_update_dpp(0, __builtin_bit_cast(int, v), 0x111, 0xf, 0xf, true));
                            v += __builtin_bit_cast(float, __builtin_amdgcn_update_dpp(0, __builtin_bit_cast(int, v), 0x112, 0xf, 0xf, true));
                            v += __builtin_bit_cast(float, __builtin_amdgcn_update_dpp(0, __builtin_bit_cast(int, v), 0x114, 0xf, 0xf, true));
                            v += __builtin_bit_cast(float, __builtin_amdgcn_update_dpp(0, __builtin_bit_cast(int, v), 0x118, 0xf, 0xf, true));
                            const float rt = __builtin_bit_cast(float, __builtin_amdgcn_ds_bpermute(((lane | 15) << 2), __builtin_bit_cast(int, v)));
                            const float P = v + tot; tot += rt;
                            G[m][e] = dir ? (G[m][e] - P) : P; }
                        T[e] = tot; }
                    const float eT0 = __builtin_amdgcn_exp2f(T[0]), eT1 = __builtin_amdgcn_exp2f(T[1]);
                    if (nh < 2) { eTa[2 * nh] = eT0; eTa[2 * nh + 1] = eT1; } else { eTb[2 * nh - 4] = eT0; eTb[2 * nh - 3] = eT1; }
#pragma unroll
                    for (int m = 0; m < 4; ++m) {
                        const float b0 = dir ? G[m][0] + T[0] : G[m][0], b1 = dir ? G[m][1] + T[1] : G[m][1];
                        const float eb0 = __builtin_amdgcn_exp2f(b0), eb1 = __builtin_amdgcn_exp2f(b1);
                        const float kt0 = KC[m][0] * __builtin_amdgcn_rcpf(eb0), kt1 = KC[m][1] * __builtin_amdgcn_rcpf(eb1);
                        ebp[m][nh] = cvt_pk_bf16(eb0, eb1); ktp[m][nh] = cvt_pk_bf16(kt0, kt1);
                        asm volatile("" : "+v"(ebp[m]), "+v"(ktp[m])); }
                  }
#pragma unroll
                  for (int m = 0; m < 4; ++m) { const unsigned off = (unsigned)((row0 + ai * HALF + m * 16) * 512 + colg); *(u32x4*)(eb + off) = ebp[m]; *(u32x4*)(kt + off) = ktp[m]; }
                  if (fr == 0) { const int rowc = row0 + ai * HALF; float* p = ebl + (unsigned)((rowc >> 6) * 512 + colg); *(f32x4*)p = eTa; *(f32x4*)(p + 4) = eTb; }
                  asm volatile("" ::: "memory");
                }
#endif
        }
    }
};


struct EpiNormRes2 {
    static constexpr bool PERM = true, AFTER_DRAIN = false;
    bf16_t* xb; float* outf; const float* wpost; float scale;
    float* xbuf; unsigned* cnt; float* ss2;
    __device__ __forceinline__ void operator()(const f32x4 (&acc)[2][2][4][2], const Unit& u, int wr, int wc, int fr, int fq, PG8_LAS unsigned char* lds, int wid, int lane) const {
        PG8_LAS float* Pt = (PG8_LAS float*)lds;
        PG8_LAS float* St = Pt + 1024;
        const int tid = wid * 64 + lane;
        const int col0 = u.pn * BM + wc * 32 + 8 * fq;
        unsigned off0 = (unsigned)((u.pm * BM + wr * 64 + fr) * 1024 + col0); asm volatile("" : "+v"(off0));
        u32x2 bs[2][4][2][2]; f32x4 wv[2][2];
#pragma unroll
        for (int bj = 0; bj < 2; ++bj) { wv[bj][0] = *(const f32x4*)(wpost + col0 + bj * HALF); wv[bj][1] = *(const f32x4*)(wpost + col0 + bj * HALF + 4);
#pragma unroll
            for (int ai = 0; ai < 2; ++ai)
#pragma unroll
                for (int m = 0; m < 4; ++m) { const bf16_t* p_ = xb + off0 + (unsigned)((ai * HALF + m * 16) * 1024 + bj * HALF); bs[ai][m][bj][0] = *(const u32x2*)p_; bs[ai][m][bj][1] = *(const u32x2*)(p_ + 4); } }
#pragma unroll
        for (int ai = 0; ai < 2; ++ai)
#pragma unroll
            for (int m = 0; m < 4; ++m) { float s = 0.f;
#pragma unroll
                for (int bj = 0; bj < 2; ++bj)
#pragma unroll
                    for (int n = 0; n < 2; ++n) { const f32x4 x = acc[ai][bj][m][n]; s += (x[0] * x[0] + x[1] * x[1]) + (x[2] * x[2] + x[3] * x[3]); }
                s += __shfl_xor(s, 16); s += __shfl_xor(s, 32);
                if (fq == 0) Pt[(ai * HALF + wr * 64 + m * 16 + fr) * 4 + wc] = s; }
        asm volatile("s_waitcnt lgkmcnt(0)" ::: "memory"); __builtin_amdgcn_s_barrier(); asm volatile("" ::: "memory");
        if (tid < 256) { const f32x4 p = *(const PG8_LAS f32x4*)(Pt + tid * 4); const float tot = (p[0] + p[1]) + (p[2] + p[3]);
            float* sl = xbuf + (size_t)(u.pm * BM + tid) * 4;
            __hip_atomic_store(sl + u.pn, tot, __ATOMIC_RELAXED, __HIP_MEMORY_SCOPE_AGENT);
            float t0, t1, t2, t3; unsigned sp = 0;
            for (;;) {
                t0 = __hip_atomic_load(sl + 0, __ATOMIC_RELAXED, __HIP_MEMORY_SCOPE_AGENT); t1 = __hip_atomic_load(sl + 1, __ATOMIC_RELAXED, __HIP_MEMORY_SCOPE_AGENT);
                t2 = __hip_atomic_load(sl + 2, __ATOMIC_RELAXED, __HIP_MEMORY_SCOPE_AGENT); t3 = __hip_atomic_load(sl + 3, __ATOMIC_RELAXED, __HIP_MEMORY_SCOPE_AGENT);
                const int bad = (__builtin_bit_cast(int, t0) | __builtin_bit_cast(int, t1) | __builtin_bit_cast(int, t2) | __builtin_bit_cast(int, t3)) < 0;
                if (!__any(bad)) break;
                if (++sp > (1u << 16)) break;
                __builtin_amdgcn_s_sleep(1);
            }
            St[tid] = scale * __builtin_amdgcn_rsqf(((t0 + t1) + (t2 + t3)) * (1.0f / 1024.0f) + 1e-6f); }
        asm volatile("s_waitcnt vmcnt(0) lgkmcnt(0)" ::: "memory"); __builtin_amdgcn_s_barrier(); asm volatile("" ::: "memory");
        float q[2][4];
#pragma unroll
        for (int ai = 0; ai < 2; ++ai)
#pragma unroll
            for (int m = 0; m < 4; ++m) { const float r = St[ai * HALF + wr * 64 + m * 16 + fr]; float qq = 0.f;
#pragma unroll
                for (int bj = 0; bj < 2; ++bj) { const unsigned off = off0 + (unsigned)((ai * HALF + m * 16) * 1024 + bj * HALF); const u32x4 bw = {bs[ai][m][bj][0].x, bs[ai][m][bj][0].y, bs[ai][m][bj][1].x, bs[ai][m][bj][1].y};
                    const f32x4 b0 = {__builtin_bit_cast(float, bw.x << 16), __builtin_bit_cast(float, bw.x & 0xffff0000u), __builtin_bit_cast(float, bw.y << 16), __builtin_bit_cast(float, bw.y & 0xffff0000u)};
                    const f32x4 b1 = {__builtin_bit_cast(float, bw.z << 16), __builtin_bit_cast(float, bw.z & 0xffff0000u), __builtin_bit_cast(float, bw.w << 16), __builtin_bit_cast(float, bw.w & 0xffff0000u)};
                    const f32x4 x0 = b0 + acc[ai][bj][m][0] * wv[bj][0] * r, x1 = b1 + acc[ai][bj][m][1] * wv[bj][1] * r;
                    if (outf) { *(f32x4*)(outf + off) = x0; *(f32x4*)(outf + off + 4) = x1; }
                    else { u32x4 w; w.x = cvt_pk_bf16(x0[0], x0[1]); w.y = cvt_pk_bf16(x0[2], x0[3]); w.z = cvt_pk_bf16(x1[0], x1[1]); w.w = cvt_pk_bf16(x1[2], x1[3]); *(u32x4*)(xb + off) = w;
#pragma unroll
                        for (int k = 0; k < 4; ++k) { const float a = __builtin_bit_cast(float, w[k] << 16), b2 = __builtin_bit_cast(float, w[k] & 0xffff0000u); qq += a * a + b2 * b2; } } }
                q[ai][m] = qq; }
        if (!outf) {
#pragma unroll
            for (int ai = 0; ai < 2; ++ai)
#pragma unroll
                for (int m = 0; m < 4; ++m) { float s = q[ai][m]; s += __shfl_xor(s, 16); s += __shfl_xor(s, 32); if (fq == 0) Pt[(ai * HALF + wr * 64 + m * 16 + fr) * 4 + wc] = s; }
        }
        asm volatile("s_waitcnt lgkmcnt(0)" ::: "memory"); __builtin_amdgcn_s_barrier(); asm volatile("" ::: "memory");
        if (!outf && tid < 256) { const f32x4 p = *(const PG8_LAS f32x4*)(Pt + tid * 4); ss2[(unsigned)((u.pm * BM + tid) * 4 + u.pn)] = (p[0] + p[1]) + (p[2] + p[3]); }
    }
};
template <class Epi, class Sched, bool ALIGN_EPI = false, bool SP2 = false>
__device__ __forceinline__ void gemm_phase(PG8_LAS unsigned char* lds, const Gemm g, const Sched& S, const Epi& E) {
    int tid_ = threadIdx.x; asm volatile("" : "+v"(tid_));
    const int tid = tid_, wid = __builtin_amdgcn_readfirstlane(tid >> 6), lane = tid & 63, wr = wid >> 2, wc = wid & 3, fr = lane & 15, fq = lane >> 4;
    const int K = g.K, nt = K / BK;
    unsigned voffA[2], voffB[2];
#pragma unroll
    for (int i = 0; i < 2; ++i) { int R, C; stage_rc(tid * 16 + i * 8192, R, C); const int Rb = Epi::PERM ? ((R & ~31) + perm32(R & 31)) : R;
        voffA[i] = (unsigned)(R * K + C) * 2u; voffB[i] = (unsigned)(Rb * K + C) * 2u; }
    const size_t kstep = (size_t)(BK * 2);
    const size_t hstep = (size_t)HALF * K * 2;
    const size_t tstep = 2 * hstep;
    const unsigned ldsw = (unsigned)wid * 1024u;
    const int aoff = lds_byte(wr * 64 + fr, fq * 8), boff = lds_byte(wc * 32 + fr, fq * 8);
#define PG8_SA(b, h) (((b) * 2 + (h)) * HTB)
#define PG8_SB(b, h) ((4 + (b) * 2 + (h)) * HTB)
#define PG8_STAGE(bufoff, gbase, voff) do { _Pragma("unroll") for (int _i = 0; _i < 2; ++_i) \
        __builtin_amdgcn_global_load_lds((const unsigned*)((const char*)(gbase) + (voff)[_i]), (PG8_LAS unsigned*)(lds + (bufoff) + ldsw + _i * 8192), 16, 0, 0); } while (0)
#define PG8_LDA(dst, b, h) do { _Pragma("unroll") for (int m = 0; m < 4; ++m) _Pragma("unroll") for (int k = 0; k < 2; ++k) dst[m][k] = *(const PG8_LAS bf16x8*)(lds + PG8_SA(b, h) + aoff + m * 2048 + k * 1024); } while (0)
#define PG8_LDB(dst, b, h) do { _Pragma("unroll") for (int n = 0; n < 2; ++n) _Pragma("unroll") for (int k = 0; k < 2; ++k) dst[n][k] = *(const PG8_LAS bf16x8*)(lds + PG8_SB(b, h) + boff + n * 2048 + k * 1024); } while (0)
#define PG8_MMA(ai, bj, At, Bt) do { __builtin_amdgcn_s_setprio(1); _Pragma("unroll") for (int m = 0; m < 4; ++m) _Pragma("unroll") for (int n = 0; n < 2; ++n) _Pragma("unroll") for (int k = 0; k < 2; ++k) \
        acc[ai][bj][m][n] = __builtin_amdgcn_mfma_f32_16x16x32_bf16(Bt[n][k], At[m][k], acc[ai][bj][m][n], 0, 0, 0); __builtin_amdgcn_s_setprio(0); } while (0)
#define PG8_WAIT_V(n) asm volatile("s_waitcnt vmcnt(" #n ")" ::: "memory")
#define PG8_WAIT_L(n) asm volatile("s_waitcnt lgkmcnt(" #n ")" ::: "memory")
#define PG8_BAR __builtin_amdgcn_s_barrier()
#define PG8_SCHED __builtin_amdgcn_sched_barrier(0)
    Unit cur, nxt; int ui = 0;
    if (!S.next(0, cur)) return;
    f32x4 acc[2][2][4][2];
#pragma unroll
    for (int a = 0; a < 2; ++a)
#pragma unroll
        for (int b = 0; b < 2; ++b)
#pragma unroll
            for (int m = 0; m < 4; ++m)
#pragma unroll
                for (int n = 0; n < 2; ++n) acc[a][b][m][n] = (f32x4){0.f, 0.f, 0.f, 0.f};
    bf16x8 At[4][2], B0[2][2], B1[2][2];
    const char* cA = (const char*)g.A + (size_t)cur.pm * tstep; const char* cB = (const char*)g.Bt + (size_t)cur.pn * tstep;
    S.a_ready(cur);
    if constexpr (SP2) {
        PG8_STAGE(PG8_SB(0, 0), cB, voffB); PG8_STAGE(PG8_SB(0, 1), cB + hstep, voffB); PG8_STAGE(PG8_SA(0, 0), cA, voffA); PG8_STAGE(PG8_SA(0, 1), cA + hstep, voffA);
        if (wr == 1) PG8_BAR;
        PG8_WAIT_V(2); PG8_BAR;
        PG8_STAGE(PG8_SB(1, 0), cB + kstep, voffB); PG8_STAGE(PG8_SA(1, 0), cA + kstep, voffA); PG8_STAGE(PG8_SB(1, 1), cB + hstep + kstep, voffB);
        PG8_WAIT_V(6); PG8_BAR;
    } else {
        PG8_STAGE(PG8_SB(0, 0), cB, voffB); PG8_STAGE(PG8_SA(0, 0), cA, voffA); PG8_STAGE(PG8_SB(0, 1), cB + hstep, voffB); PG8_STAGE(PG8_SA(0, 1), cA + hstep, voffA);
        if (wr == 1) PG8_BAR;
        PG8_WAIT_V(4); PG8_BAR;
        PG8_STAGE(PG8_SB(1, 0), cB + kstep, voffB); PG8_STAGE(PG8_SA(1, 0), cA + kstep, voffA); PG8_STAGE(PG8_SB(1, 1), cB + hstep + kstep, voffB);
        PG8_WAIT_V(6); PG8_BAR;
    }
    for (;;) {
        const bool has_next = S.next(ui + 1, nxt);
        const char* nA = has_next ? (const char*)g.A + (size_t)nxt.pm * tstep : cA; const char* nB = has_next ? (const char*)g.Bt + (size_t)nxt.pn * tstep : cB;
        for (int t = 0; t < nt; t += 2) {
            const bool last = (t == nt - 2);
            const char* a1 = cA + (size_t)(t + 1) * kstep;
            const char* a2 = last ? nA : cA + (size_t)(t + 2) * kstep; const char* b2 = last ? nB : cB + (size_t)(t + 2) * kstep;
            const char* a3 = a2 + kstep; const char* b3 = b2 + kstep;
            if (last && has_next) S.a_ready(nxt);
            if constexpr (SP2) {
            PG8_LDB(B0, 0, 0); PG8_LDB(B1, 0, 1); PG8_SCHED; PG8_LDA(At, 0, 0); PG8_STAGE(PG8_SA(1, 1), a1 + hstep, voffA);
            PG8_WAIT_V(8); PG8_WAIT_L(0); PG8_BAR; PG8_MMA(0, 0, At, B0); PG8_MMA(0, 1, At, B1); PG8_BAR; PG8_SCHED;
            PG8_LDA(At, 0, 1); PG8_STAGE(PG8_SB(0, 0), b2, voffB); PG8_STAGE(PG8_SB(0, 1), b2 + hstep, voffB); PG8_STAGE(PG8_SA(0, 0), a2, voffA);
            PG8_WAIT_V(8); PG8_WAIT_L(0); PG8_BAR; PG8_MMA(1, 0, At, B0); PG8_MMA(1, 1, At, B1); PG8_BAR; PG8_SCHED;
            PG8_LDB(B0, 1, 0); PG8_LDB(B1, 1, 1); PG8_SCHED; PG8_LDA(At, 1, 0); PG8_STAGE(PG8_SA(0, 1), a2 + hstep, voffA);
            PG8_WAIT_V(8); PG8_WAIT_L(0); PG8_BAR; PG8_MMA(0, 0, At, B0); PG8_MMA(0, 1, At, B1); PG8_BAR; PG8_SCHED;
            PG8_LDA(At, 1, 1); PG8_STAGE(PG8_SB(1, 0), b3, voffB); PG8_STAGE(PG8_SB(1, 1), b3 + hstep, voffB); PG8_STAGE(PG8_SA(1, 0), a3, voffA);
            PG8_WAIT_V(8); PG8_WAIT_L(0); PG8_BAR; PG8_MMA(1, 0, At, B0); PG8_MMA(1, 1, At, B1); PG8_BAR; PG8_SCHED;
            } else {
            PG8_LDB(B0, 0, 0); PG8_SCHED; PG8_LDA(At, 0, 0); PG8_STAGE(PG8_SA(1, 1), a1 + hstep, voffA);
            PG8_WAIT_L(8); PG8_BAR; PG8_WAIT_L(0); PG8_MMA(0, 0, At, B0); PG8_BAR; PG8_SCHED;
            PG8_LDB(B1, 0, 1); PG8_STAGE(PG8_SB(0, 0), b2, voffB);
            PG8_BAR; PG8_WAIT_L(0); PG8_MMA(0, 1, At, B1); PG8_BAR;
            PG8_LDA(At, 0, 1); PG8_STAGE(PG8_SA(0, 0), a2, voffA);
            PG8_BAR; PG8_WAIT_L(0); PG8_MMA(1, 0, At, B0); PG8_BAR; PG8_SCHED;
            PG8_STAGE(PG8_SB(0, 1), b2 + hstep, voffB);
            PG8_WAIT_V(6); PG8_BAR; PG8_MMA(1, 1, At, B1); PG8_BAR;
            PG8_LDB(B0, 1, 0); PG8_SCHED; PG8_LDA(At, 1, 0); PG8_STAGE(PG8_SA(0, 1), a2 + hstep, voffA);
            PG8_WAIT_L(8); PG8_BAR; PG8_WAIT_L(0); PG8_MMA(0, 0, At, B0); PG8_BAR; PG8_SCHED;
            PG8_LDB(B1, 1, 1); PG8_STAGE(PG8_SB(1, 0), b3, voffB);
            PG8_BAR; PG8_WAIT_L(0); PG8_MMA(0, 1, At, B1); PG8_BAR;
            PG8_LDA(At, 1, 1); PG8_STAGE(PG8_SA(1, 0), a3, voffA);
            PG8_BAR; PG8_WAIT_L(0); PG8_MMA(1, 0, At, B0); PG8_BAR; PG8_SCHED;
            PG8_STAGE(PG8_SB(1, 1), b3 + hstep, voffB);
            PG8_WAIT_V(6); PG8_BAR; PG8_MMA(1, 1, At, B1); PG8_BAR;
            }
        }
        if constexpr (ALIGN_EPI) { if (wr == 0) PG8_BAR; }
        if constexpr (!Epi::AFTER_DRAIN) { E(acc, cur, wr, wc, fr, fq, lds + STAGE_BYTES, wid, lane); S.done(cur); }
        if (!has_next) break;
#pragma unroll
        for (int a = 0; a < 2; ++a)
#pragma unroll
            for (int b = 0; b < 2; ++b)
#pragma unroll
                for (int m = 0; m < 4; ++m)
#pragma unroll
                    for (int n = 0; n < 2; ++n) acc[a][b][m][n] = (f32x4){0.f, 0.f, 0.f, 0.f};
        cur = nxt; cA = nA; cB = nB; ++ui;
        if constexpr (ALIGN_EPI) { if (wr == 1) PG8_BAR; }
    }
    PG8_WAIT_V(0);
    if constexpr (!ALIGN_EPI) { if (wr == 0) PG8_BAR; }
    PG8_BAR;
    if constexpr (Epi::AFTER_DRAIN) { E.fused(acc, cur, wr, wc, fr, fq, lds, wid, lane); S.done(cur); }
#undef PG8_SA
#undef PG8_SB
#undef PG8_STAGE
#undef PG8_LDA
#undef PG8_LDB
#undef PG8_MMA
#undef PG8_WAIT_V
#undef PG8_WAIT_L
#undef PG8_BAR
#undef PG8_SCHED
}
}
#define LAS __attribute__((address_space(3)))
typedef unsigned short bf16;
typedef unsigned v4u __attribute__((ext_vector_type(4)));
typedef unsigned v2u __attribute__((ext_vector_type(2)));
typedef float f32x4 __attribute__((ext_vector_type(4)));
typedef short bf16x8 __attribute__((ext_vector_type(8)));
typedef short s16x4 __attribute__((ext_vector_type(4)));
constexpr int NWAVES = 8, NTHR = 512;

#define XB_TMO      128
#define XB_XCNT(j)  (256  + 64 * (j))
#define XB_XSUB(j)  (1280 + 64 * (j))
#define XB_XGEN(j)  (2304 + 64 * (j))
#define XB_TOP      3328
#define XB_TOPGEN   3392
#define XCD_BAR_WORDS 3456
#define XB_SPIN_CAP (1u << 18)

__device__ __forceinline__ unsigned xb_ld(unsigned* p)              { return __hip_atomic_load(p, __ATOMIC_RELAXED, __HIP_MEMORY_SCOPE_AGENT); }
__device__ __forceinline__ unsigned xb_add(unsigned* p, unsigned v) { return __hip_atomic_fetch_add(p, v, __ATOMIC_RELAXED, __HIP_MEMORY_SCOPE_AGENT); }
__device__ __forceinline__ unsigned xb_xcc_id() { return (unsigned)__builtin_amdgcn_s_getreg((3 << 11) | 20) & 0xFu; }
#define XB_SPIN(cond, bar) do { unsigned _sp = 0; while (cond) { __builtin_amdgcn_s_sleep(1); \
    if ((++_sp & 255u) == 0u) { if (xb_ld(&(bar)[XB_TMO])) break; if (_sp > XB_SPIN_CAP) { atomicAdd(&(bar)[XB_TMO], 1u); break; } } } } while (0)

struct XcdBarrier {
    unsigned* bar; unsigned x;
    volatile LAS unsigned* st;
};

__device__ __forceinline__ XcdBarrier xcd_barrier_post(unsigned* bar, volatile LAS unsigned* st) {
    XcdBarrier b; b.bar = bar; b.x = xb_xcc_id(); b.st = st;
    if (threadIdx.x == 0) (void)xb_add(&bar[XB_XCNT(b.x)], 1u);
    return b;
}
__device__ __forceinline__ void xcd_barrier_complete(unsigned* bar, unsigned x, unsigned& nloc, unsigned& nx) {
    const unsigned G = gridDim.x * gridDim.y * gridDim.z;
    unsigned sum, cnt, mine, sp = 0u;
    for (;;) {
        sum = 0u; cnt = 0u; mine = 0u;
#pragma unroll
        for (unsigned j = 0; j < 16; ++j) { const unsigned c = xb_ld(&bar[XB_XCNT(j)]); sum += c; cnt += (c > 0u) ? 1u : 0u; mine = (j == x) ? c : mine; }
        if (sum == G) break;
        __builtin_amdgcn_s_sleep(1);
        if ((++sp & 255u) == 0u) { if (xb_ld(&bar[XB_TMO])) break; if (sp > XB_SPIN_CAP) { atomicAdd(&bar[XB_TMO], 1u); break; } }
    }
    nloc = mine > 0u ? mine : 1u; nx = cnt > 0u ? cnt : 1u;
}

__device__ __forceinline__ void xcd_barrier(const XcdBarrier& b) {
    asm volatile("s_waitcnt vmcnt(0)" ::: "memory");
    __syncthreads();
    if (threadIdx.x == 0) {
        unsigned* bar = b.bar;
        __builtin_amdgcn_s_waitcnt(0);
        unsigned nloc = b.st[0], nx = b.st[1];
        if (nloc == 0u) { xcd_barrier_complete(bar, b.x, nloc, nx); b.st[0] = nloc; b.st[1] = nx; }
        const unsigned old = xb_add(&bar[XB_XSUB(b.x)], 1u);
        const unsigned gen = old / nloc;
        if (old + 1u == (gen + 1u) * nloc) {
            __builtin_amdgcn_fence(__ATOMIC_RELEASE, "agent");
            asm volatile("s_waitcnt vmcnt(0)" ::: "memory");
            const unsigned og = xb_add(&bar[XB_TOP], 1u);
            const unsigned tg = og / nx;
            if (og + 1u == (tg + 1u) * nx) xb_add(&bar[XB_TOPGEN], 1u);
            else XB_SPIN(xb_ld(&bar[XB_TOPGEN]) == tg, bar);
            __builtin_amdgcn_fence(__ATOMIC_ACQUIRE, "agent");
            xb_add(&bar[XB_XGEN(b.x)], 1u);
            asm volatile("s_waitcnt vmcnt(0)" ::: "memory");
        } else {
            XB_SPIN(xb_ld(&bar[XB_XGEN(b.x)]) == gen, bar);
            __builtin_amdgcn_fence(__ATOMIC_ACQUIRE, "agent");
            asm volatile("s_waitcnt vmcnt(0)" ::: "memory");
        }
    }
    __syncthreads();
}

__device__ __forceinline__ unsigned pk2(float lo, float hi) { return pg8::cvt_pk_bf16(lo, hi); }
__device__ __forceinline__ float bf_lo(unsigned w) { return __builtin_bit_cast(float, w << 16); }
__device__ __forceinline__ float bf_hi(unsigned w) { return __builtin_bit_cast(float, w & 0xffff0000u); }
__device__ __forceinline__ float wave_sum(float v) {
#pragma unroll
    for (int o = 1; o < 64; o <<= 1) v += __shfl_xor(v, o);
    return v;
}
__device__ __forceinline__ float row16_sum(float v) {
    v += __builtin_bit_cast(float, __builtin_amdgcn_update_dpp(0, __builtin_bit_cast(int, v), 0x128, 0xf, 0xf, false));
    v += __builtin_bit_cast(float, __builtin_amdgcn_update_dpp(0, __builtin_bit_cast(int, v), 0x124, 0xf, 0xf, false));
    v += __builtin_bit_cast(float, __builtin_amdgcn_update_dpp(0, __builtin_bit_cast(int, v), 0x122, 0xf, 0xf, false));
    v += __builtin_bit_cast(float, __builtin_amdgcn_update_dpp(0, __builtin_bit_cast(int, v), 0x121, 0xf, 0xf, false));
    return v;
}
struct Params {
    const float* in[20]; float* out; unsigned char* ws;
};

__device__ __forceinline__ void transpose_item(const float* W, int K, int N, bf16* WT, int mode, LAS float* scr, int item, int lane, const float* kscale = nullptr) {
    const int nblk = N / 32, kb = item / nblk, nb = item % nblk, k0 = 64 * kb, n0 = 32 * nb;
    const int r0 = mode == 0 ? n0 : ((n0 >> 7) * 256 + (n0 & 127) + (mode == 2 ? 128 : 0));
#pragma unroll 8
    for (int i = 0; i < 32; ++i) { const int kk = 2 * i + (lane >> 5); float wv = W[(size_t)(k0 + kk) * N + n0 + (lane & 31)]; if (kscale) wv *= kscale[k0 + kk]; scr[kk * 33 + (lane & 31)] = wv; }
    asm volatile("s_waitcnt lgkmcnt(0)" ::: "memory");
    const int c = lane & 7;
#pragma unroll
    for (int j = 0; j < 4; ++j) { const int n = (lane >> 3) + 8 * j; const LAS float* s = scr + (8 * c) * 33 + n;
        v4u o; o.x = pk2(s[0 * 33], s[1 * 33]); o.y = pk2(s[2 * 33], s[3 * 33]); o.z = pk2(s[4 * 33], s[5 * 33]); o.w = pk2(s[6 * 33], s[7 * 33]);
        *(v4u*)(WT + (size_t)(r0 + n) * K + k0 + 8 * c) = o; }
    asm volatile("s_waitcnt lgkmcnt(0)" ::: "memory");
}

template <int MODE>
__device__ __forceinline__ void row_pass2(const float* xin, bf16* XB, const bf16* Y, const float* wpost, float scale, float* xout, float* R2, int gw, int NGW, int lane) {
    constexpr int RB = 2;
    struct Stage { f32x4 v[RB][4]; v2u xw[RB][4]; v2u yw[RB][4]; };
    Stage st[2];
#define RP_LOAD(S_, m0_) do { _Pragma("unroll") for (int r = 0; r < RB; ++r) { \
            if (MODE <= 1) { const f32x4* xr = (const f32x4*)(xin + (size_t)((m0_) + r) * D_MODEL) + lane; _Pragma("unroll") for (int j = 0; j < 4; ++j) S_.v[r][j] = xr[64 * j]; } \
            else { const v2u* xr = (const v2u*)(XB + (size_t)((m0_) + r) * D_MODEL) + lane; _Pragma("unroll") for (int j = 0; j < 4; ++j) S_.xw[r][j] = xr[64 * j]; } \
            if (MODE >= 1) { const v2u* yr = (const v2u*)(Y + (size_t)((m0_) + r) * D_MODEL) + lane; _Pragma("unroll") for (int j = 0; j < 4; ++j) S_.yw[r][j] = yr[64 * j]; } } } while (0)
#define RP_COMPUTE(S_, m0_) do { _Pragma("unroll") for (int r = 0; r < RB; ++r) { const int m = (m0_) + r; f32x4 v[4]; \
            _Pragma("unroll") for (int j = 0; j < 4; ++j) { if (MODE <= 1) v[j] = S_.v[r][j]; else { const v2u w = S_.xw[r][j]; v[j] = (f32x4){bf_lo(w.x), bf_hi(w.x), bf_lo(w.y), bf_hi(w.y)}; } } \
            if (MODE >= 1) { f32x4 y[4]; float ss = 0.f; \
                _Pragma("unroll") for (int j = 0; j < 4; ++j) { const v2u w = S_.yw[r][j]; y[j] = (f32x4){bf_lo(w.x), bf_hi(w.x), bf_lo(w.y), bf_hi(w.y)}; ss += (y[j].x * y[j].x + y[j].y * y[j].y) + (y[j].z * y[j].z + y[j].w * y[j].w); } \
                const float rr = scale * __builtin_amdgcn_rsqf(wave_sum(ss) * (1.f / D_MODEL) + EPS); \
                _Pragma("unroll") for (int j = 0; j < 4; ++j) { const f32x4 w = ((const f32x4*)wpost)[lane + 64 * j]; v[j] = v[j] + y[j] * w * rr; } } \
            if (MODE == 3) { f32x4* xo = (f32x4*)(xout + (size_t)m * D_MODEL) + lane; _Pragma("unroll") for (int j = 0; j < 4; ++j) __builtin_nontemporal_store(v[j], xo + 64 * j); } \
            else { float ss = 0.f; v2u* o = (v2u*)(XB + (size_t)m * D_MODEL) + lane; \
                _Pragma("unroll") for (int j = 0; j < 4; ++j) { const v2u w = (v2u){pk2(v[j].x, v[j].y), pk2(v[j].z, v[j].w)}; o[64 * j] = w; \
                    const float a = bf_lo(w.x), b2 = bf_hi(w.x), c = bf_lo(w.y), d = bf_hi(w.y); ss += (a * a + b2 * b2) + (c * c + d * d); } \
                ss = wave_sum(ss); if (lane == 0) *(f32x4*)(R2 + (size_t)m * 4) = (f32x4){ss, 0.f, 0.f, 0.f}; } } } while (0)
    const int stride = NGW * RB;
    int m0 = gw * RB;
    if (m0 < MTOK) RP_LOAD(st[0], m0);
    for (; m0 < MTOK; m0 += 2 * stride) {
        if (m0 + stride < MTOK) RP_LOAD(st[1], m0 + stride);
        RP_COMPUTE(st[0], m0);
        if (m0 + stride < MTOK) { if (m0 + 2 * stride < MTOK) RP_LOAD(st[0], m0 + 2 * stride); RP_COMPUTE(st[1], m0 + stride); }
    }
#undef RP_LOAD
#undef RP_COMPUTE
}

__device__ __forceinline__ s16x4 tr_read(const LAS bf16* p) { typedef short v4i16_t __attribute__((ext_vector_type(4))); return __builtin_bit_cast(s16x4, __builtin_amdgcn_ds_read_tr16_b64_v4i16((LAS v4i16_t*)p)); }
__device__ __forceinline__ bf16x8 cat4(s16x4 a, s16x4 b) { return (bf16x8){a[0], a[1], a[2], a[3], b[0], b[1], b[2], b[3]}; }
#define MFMA16(a, b, c) __builtin_amdgcn_mfma_f32_16x16x32_bf16((a), (b), (c), 0, 0, 0)

constexpr int SQ = 136, SV = 72;
struct ScanStage { v4u rq[2], re[2], rkt[2], rv; float rebl; };
__device__ __forceinline__ void scan_phase(LAS unsigned char* lds, unsigned char* ws, int nblk, int bid, int tid) {
    asm volatile("" : "+v"(tid));
    LAS bf16* QT = (LAS bf16*)lds;
    LAS bf16* KTs = QT + 64 * SQ;
    LAS bf16* Vs = KTs + 64 * SQ;
    LAS bf16* Ps = Vs + 64 * SV;
    LAS bf16* Ss = Ps + 64 * SV;
    LAS float* EBLs = (LAS float*)(Ss + 128 * SV);
    const int lane = tid & 63, w = __builtin_amdgcn_readfirstlane(tid >> 6), g = lane >> 4, l15 = lane & 15, q4 = l15 >> 2, p4 = lane & 3;
    const bf16* HQ = (const bf16*)(ws + WS_HQ); const bf16* HV = (const bf16*)(ws + WS_HV);
    for (int item = bid; item < 256; item += nblk) {
        const int vh = item & 1, dir = (item >> 1) & 1, h = (item >> 2) & 3, b = item >> 4;
        const bf16* KT = (const bf16*)(ws + WS_KT) + (size_t)dir * MTOK * 512;
        const bf16* EB = (const bf16*)(ws + WS_EB) + (size_t)dir * MTOK * 512; const float* EBL = (const float*)(ws + WS_EBL) + (size_t)dir * (MTOK / 64) * 512;
        bf16* OD = (bf16*)(ws + WS_Y) + (size_t)dir * MTOK * 512;
        f32x4 sacc[4];
#pragma unroll
        for (int c = 0; c < 4; ++c) sacc[c] = (f32x4){0.f, 0.f, 0.f, 0.f};
        const int prow0 = tid >> 4, pc8 = tid & 15, vrow = tid >> 3, vc8 = tid & 7;
        ScanStage st[2];
#define SCAN_ISSUE(S_, stp) do { const int c_ = dir ? 63 - (stp) : (stp); const size_t rb_ = (size_t)b * SEQ + (size_t)c_ * 64; \
            _Pragma("unroll") for (int i = 0; i < 2; ++i) { const size_t off_ = (rb_ + prow0 + 32 * i) * 512 + h * 128 + 8 * pc8; \
                S_.rq[i] = *(const v4u*)(HQ + off_); S_.re[i] = *(const v4u*)(EB + off_); S_.rkt[i] = *(const v4u*)(KT + off_); } \
            S_.rv = *(const v4u*)(HV + (rb_ + vrow) * 512 + h * 128 + vh * 64 + 8 * vc8); \
            S_.rebl = (tid < 128) ? EBL[((size_t)b * 64 + c_) * 512 + h * 128 + tid] : 0.f; } while (0)
        SCAN_ISSUE(st[0], 0); SCAN_ISSUE(st[1], 1);
        __syncthreads();
#define SCAN_STEP(S_, step) do { \
            const int c = dir ? 63 - (step) : (step); \
              \
            _Pragma("unroll") for (int i = 0; i < 2; ++i) { const int row = prow0 + 32 * i; v4u qt; \
                qt.x = pk2(bf_lo(S_.rq[i].x) * bf_lo(S_.re[i].x), bf_hi(S_.rq[i].x) * bf_hi(S_.re[i].x)); qt.y = pk2(bf_lo(S_.rq[i].y) * bf_lo(S_.re[i].y), bf_hi(S_.rq[i].y) * bf_hi(S_.re[i].y)); \
                qt.z = pk2(bf_lo(S_.rq[i].z) * bf_lo(S_.re[i].z), bf_hi(S_.rq[i].z) * bf_hi(S_.re[i].z)); qt.w = pk2(bf_lo(S_.rq[i].w) * bf_lo(S_.re[i].w), bf_hi(S_.rq[i].w) * bf_hi(S_.re[i].w)); \
                *(LAS v4u*)(QT + row * SQ + 8 * pc8) = qt; *(LAS v4u*)(KTs + row * SQ + 8 * pc8) = S_.rkt[i]; } \
            *(LAS v4u*)(Vs + vrow * SV + 8 * vc8) = S_.rv; \
            if (tid < 128) EBLs[tid] = S_.rebl; \
            _Pragma("unroll") for (int cc = 0; cc < 4; ++cc) *(LAS v2u*)(Ss + (16 * w + l15) * SV + 16 * cc + 4 * g) = (v2u){pk2(sacc[cc][0], sacc[cc][1]), pk2(sacc[cc][2], sacc[cc][3])}; \
            __syncthreads(); \
            if ((step) + 2 < 64) SCAN_ISSUE(S_, (step) + 2); \
              \
            const int si = w >> 1, tj0 = 2 * (w & 1); \
            bf16x8 bq[2][4]; \
            _Pragma("unroll") for (int j = 0; j < 2; ++j) _Pragma("unroll") for (int ks = 0; ks < 4; ++ks) bq[j][ks] = *(const LAS bf16x8*)(QT + (16 * (tj0 + j) + l15) * SQ + 32 * ks + 8 * g); \
            { bf16x8 ak[4]; \
                _Pragma("unroll") for (int ks = 0; ks < 4; ++ks) ak[ks] = *(const LAS bf16x8*)(KTs + (16 * si + l15) * SQ + 32 * ks + 8 * g); \
                _Pragma("unroll") for (int j = 0; j < 2; ++j) { f32x4 d = {0.f, 0.f, 0.f, 0.f}; \
                    _Pragma("unroll") for (int ks = 0; ks < 4; ++ks) d = MFMA16(ak[ks], bq[j][ks], d); \
                    const int t = 16 * (tj0 + j) + l15, s0 = 16 * si + 4 * g; \
                    _Pragma("unroll") for (int r = 0; r < 4; ++r) { const bool keep = dir ? (s0 + r >= t) : (s0 + r <= t); if (!keep) d[r] = 0.f; } \
                    *(LAS v2u*)(Ps + t * SV + s0) = (v2u){pk2(d[0], d[1]), pk2(d[2], d[3])}; } } \
            f32x4 oacc[2]; \
            { bf16x8 as_[4]; \
                _Pragma("unroll") for (int ks = 0; ks < 4; ++ks) { const s16x4 a0 = tr_read(Ss + (32 * ks + 8 * g + q4) * SV + 16 * si + 4 * p4), a1 = tr_read(Ss + (32 * ks + 8 * g + 4 + q4) * SV + 16 * si + 4 * p4); as_[ks] = cat4(a0, a1); } \
                _Pragma("unroll") for (int j = 0; j < 2; ++j) { f32x4 d = {0.f, 0.f, 0.f, 0.f}; \
                    _Pragma("unroll") for (int ks = 0; ks < 4; ++ks) d = MFMA16(as_[ks], bq[j][ks], d); \
                    oacc[j] = d; } } \
            __syncthreads(); \
              \
            { bf16x8 av[2]; \
                _Pragma("unroll") for (int ks = 0; ks < 2; ++ks) { const s16x4 a0 = tr_read(Vs + (32 * ks + 8 * g + q4) * SV + 16 * si + 4 * p4), a1 = tr_read(Vs + (32 * ks + 8 * g + 4 + q4) * SV + 16 * si + 4 * p4); av[ks] = cat4(a0, a1); } \
                _Pragma("unroll") for (int j = 0; j < 2; ++j) { const int t = 16 * (tj0 + j) + l15; \
                    _Pragma("unroll") for (int ks = 0; ks < 2; ++ks) { const bf16x8 bp = *(const LAS bf16x8*)(Ps + t * SV + 32 * ks + 8 * g); oacc[j] = MFMA16(av[ks], bp, oacc[j]); } \
                    *(v2u*)(OD + ((size_t)b * SEQ + (size_t)c * 64 + t) * 512 + h * 128 + vh * 64 + 16 * si + 4 * g) = (v2u){pk2(oacc[j][0], oacc[j][1]), pk2(oacc[j][2], oacc[j][3])}; } } \
            { const float el = EBLs[16 * w + l15]; \
                bf16x8 bk[2]; \
                _Pragma("unroll") for (int ks = 0; ks < 2; ++ks) { const s16x4 a0 = tr_read(KTs + (32 * ks + 8 * g + q4) * SQ + 16 * w + 4 * p4), a1 = tr_read(KTs + (32 * ks + 8 * g + 4 + q4) * SQ + 16 * w + 4 * p4); bk[ks] = cat4(a0, a1); } \
                _Pragma("unroll") for (int cc = 0; cc < 4; ++cc) { \
                    _Pragma("unroll") for (int ks = 0; ks < 2; ++ks) { const s16x4 a0 = tr_read(Vs + (32 * ks + 8 * g + q4) * SV + 16 * cc + 4 * p4), a1 = tr_read(Vs + (32 * ks + 8 * g + 4 + q4) * SV + 16 * cc + 4 * p4); \
                        sacc[cc] = MFMA16(cat4(a0, a1), bk[ks], sacc[cc]); } \
                    sacc[cc] = sacc[cc] * el; } } \
            __syncthreads(); \
        } while (0)
        for (int step = 0; step < 64; step += 2) { SCAN_STEP(st[0], step); SCAN_STEP(st[1], step + 1); }
#undef SCAN_STEP
#undef SCAN_ISSUE
    }
}

constexpr int NKEY = 320, NKEYV = 336, SK = 72;
__device__ __forceinline__ void attn_phase(LAS unsigned char* lds, unsigned char* ws, const float* sink, const float* att_norm, const float* hg_norm, int nblk, int bid, int tid) {
    asm volatile("" : "+v"(tid));
    LAS bf16* Ks = (LAS bf16*)lds;
    LAS bf16* Vs = Ks + NKEY * SK;
    LAS float* SSs = (LAS float*)(Vs + NKEYV * SK);
    const int lane = tid & 63, w = __builtin_amdgcn_readfirstlane(tid >> 6), g = lane >> 4, l15 = lane & 15, q4 = l15 >> 2, p4 = lane & 3;
    const bf16* QB = (const bf16*)(ws + WS_QB); const bf16* KB = (const bf16*)(ws + WS_KB); const bf16* VB = (const bf16*)(ws + WS_VB);
    bf16* CAT = (bf16*)(ws + WS_KK);
    const int hl = w >> 1, rh = w & 1;
    constexpr int NIT = MTOK / 64;
    __syncthreads();
    for (int p = tid; p < 16 * 8; p += NTHR) *(LAS v4u*)(Vs + (NKEY + (p >> 3)) * SK + 8 * (p & 7)) = (v4u){0u, 0u, 0u, 0u};
    v4u kreg[5], vreg[5];
#define ATT_PREFETCH(item_, kvh_) do { const int b_ = (item_) >> 6, q0_ = ((item_) & 63) * 64; const size_t rb_ = (size_t)b_ * SEQ; \
        _Pragma("unroll") for (int i = 0; i < 5; ++i) { const int p = tid + NTHR * i; const int kr = p >> 3, c8 = p & 7; int pos = q0_ - 128 + kr; pos = pos < 0 ? 0 : (pos > SEQ - 1 ? SEQ - 1 : pos); \
            const size_t off = (rb_ + pos) * 128 + (kvh_) * 64 + 8 * c8; kreg[i] = *(const v4u*)(KB + off); vreg[i] = *(const v4u*)(VB + off); } \
        _Pragma("unroll") for (int r2 = 0; r2 < 2; ++r2) _Pragma("unroll") for (int ks = 0; ks < 2; ++ks) bqn[r2][ks] = *(const bf16x8*)(QB + (rb_ + q0_ + 32 * rh + 16 * r2 + l15) * 512 + ((kvh_) * 4 + hl) * 64 + 32 * ks + 8 * g); } while (0)
    bf16x8 bqn[2][2];
    const float sk2a = sink[hl] * LOG2E, sk2b = sink[4 + hl] * LOG2E;
    if (bid < NIT) ATT_PREFETCH(bid, 0);
    for (int item = bid; item < NIT; item += nblk) {
        const int b = item >> 6, q0 = (item & 63) * 64;
        const size_t rbase = (size_t)b * SEQ;
        const bool edge = (q0 < 128) || (q0 + 64 + 128 > SEQ);
#pragma unroll 1
        for (int kvh = 0; kvh < 2; ++kvh) {
            const int head = kvh * 4 + hl;
            bf16x8 bqa[2][2];
#pragma unroll
            for (int r2 = 0; r2 < 2; ++r2) { bqa[r2][0] = bqn[r2][0]; bqa[r2][1] = bqn[r2][1]; }
            __syncthreads();
#pragma unroll
            for (int i = 0; i < 5; ++i) { const int p = tid + NTHR * i; const int kr = p >> 3, c8 = p & 7; *(LAS v4u*)(Ks + kr * SK + 8 * c8) = kreg[i]; *(LAS v4u*)(Vs + kr * SK + 8 * c8) = vreg[i]; }
            __syncthreads();
            asm volatile("" : "+v"(bqa[0][0]), "+v"(bqa[0][1]), "+v"(bqa[1][0]), "+v"(bqa[1][1]));
            { const int nitem = (kvh == 0) ? item : (item + nblk < NIT ? item + nblk : item); const int nkvh = kvh ^ 1; ATT_PREFETCH(nitem, nkvh); }
            const float sk2 = kvh ? sk2b : sk2a;
#pragma unroll 1
            for (int rt = 0; rt < 2; ++rt) {
                const int kt0 = 2 * rh + rt; const int rl = 16 * kt0 + l15;
                bf16x8 bq[2];
#pragma unroll
                for (int ks = 0; ks < 2; ++ks) bq[ks] = rt ? bqa[1][ks] : bqa[0][ks];
                const LAS bf16* Kw = Ks + (16 * kt0) * SK; const LAS bf16* Vw = Vs + (16 * kt0) * SK;
                f32x4 s[17];
                {
                    bf16x8 kf[1][4][2];
                    const LAS bf16* Kl = Kw + l15 * SK + 8 * g;
#define ATT_KLOAD(buf, grp) do { _Pragma("unroll") for (int j = 0; j < 4; ++j) { if (4 * (grp) + j < 17) { _Pragma("unroll") for (int ks = 0; ks < 2; ++ks) kf[buf][j][ks] = *(const LAS bf16x8*)(Kl + (16 * (4 * (grp) + j)) * SK + 32 * ks); } } } while (0)
#define ATT_KMMA(buf, grp) do { _Pragma("unroll") for (int j = 0; j < 4; ++j) { if (4 * (grp) + j < 17) { f32x4 d = {0.f, 0.f, 0.f, 0.f}; _Pragma("unroll") for (int ks = 0; ks < 2; ++ks) d = MFMA16(kf[buf][j][ks], bq[ks], d); s[4 * (grp) + j] = d; } } } while (0)
#define ATT_SB() __builtin_amdgcn_sched_barrier(0)
                    ATT_KLOAD(0, 0); ATT_SB(); ATT_KMMA(0, 0); ATT_SB(); ATT_KLOAD(0, 1); ATT_SB(); ATT_KMMA(0, 1); ATT_SB(); ATT_KLOAD(0, 2); ATT_SB(); ATT_KMMA(0, 2); ATT_SB();
                    ATT_KLOAD(0, 3); ATT_SB(); ATT_KMMA(0, 3); ATT_SB(); ATT_KLOAD(0, 4); ATT_SB(); ATT_KMMA(0, 4); ATT_SB();
#undef ATT_KLOAD
#undef ATT_KMMA
                }
#pragma unroll
                for (int r = 0; r < 4; ++r) { if (4 * g + r - l15 < 0) s[0][r] = -1e30f; if (4 * g + r - l15 > 0) s[16][r] = -1e30f; }
                if (edge) {
#pragma unroll
                    for (int i = 0; i < 17; ++i)
#pragma unroll
                        for (int r = 0; r < 4; ++r) { const int kpos = q0 - 128 + 16 * (kt0 + i) + 4 * g + r; if (kpos < 0 || kpos >= SEQ) s[i][r] = -1e30f; } }
                float mx = sk2;
#pragma unroll
                for (int i = 0; i < 17; ++i) mx = fmaxf(fmaxf(mx, fmaxf(s[i][0], s[i][1])), fmaxf(s[i][2], s[i][3]));
                mx = fmaxf(mx, __shfl_xor(mx, 16)); mx = fmaxf(mx, __shfl_xor(mx, 32));
                float sum = 0.f;
#pragma unroll
                for (int i = 0; i < 17; ++i)
#pragma unroll
                    for (int r = 0; r < 4; ++r) { const float pv = __builtin_amdgcn_exp2f(s[i][r] - mx); s[i][r] = pv; sum += pv; }
                sum += __shfl_xor(sum, 16); sum += __shfl_xor(sum, 32);
                const float inv = __builtin_amdgcn_rcpf(sum + __builtin_amdgcn_exp2f(sk2 - mx));
                f32x4 O[4];
#pragma unroll
                for (int dt = 0; dt < 4; ++dt) O[dt] = (f32x4){0.f, 0.f, 0.f, 0.f};
                {
                    s16x4 vfr[1][4][2];
                    const LAS bf16* Vl = Vw + (4 * g + q4) * SK + 4 * p4;
#define ATT_VLOAD(buf, st) do { _Pragma("unroll") for (int dt = 0; dt < 4; ++dt) { vfr[buf][dt][0] = tr_read(Vl + (32 * (st)) * SK + 16 * dt); vfr[buf][dt][1] = tr_read(Vl + (32 * (st) + 16) * SK + 16 * dt); } } while (0)
#define ATT_PV(buf, st) do { v4u pw; pw.x = pk2(s[2 * (st)][0], s[2 * (st)][1]); pw.y = pk2(s[2 * (st)][2], s[2 * (st)][3]); \
                        if ((st) < 8) { pw.z = pk2(s[(st) < 8 ? 2 * (st) + 1 : 0][0], s[(st) < 8 ? 2 * (st) + 1 : 0][1]); pw.w = pk2(s[(st) < 8 ? 2 * (st) + 1 : 0][2], s[(st) < 8 ? 2 * (st) + 1 : 0][3]); } else { pw.z = 0u; pw.w = 0u; } \
                        const bf16x8 bp = __builtin_bit_cast(bf16x8, pw); \
                        _Pragma("unroll") for (int dt = 0; dt < 4; ++dt) O[dt] = MFMA16(cat4(vfr[buf][dt][0], vfr[buf][dt][1]), bp, O[dt]); } while (0)
                    ATT_VLOAD(0, 0); ATT_SB(); ATT_PV(0, 0); ATT_SB();
                    ATT_VLOAD(0, 1); ATT_SB(); ATT_PV(0, 1); ATT_SB();
                    ATT_VLOAD(0, 2); ATT_SB(); ATT_PV(0, 2); ATT_SB();
                    ATT_VLOAD(0, 3); ATT_SB(); ATT_PV(0, 3); ATT_SB();
                    ATT_VLOAD(0, 4); ATT_SB(); ATT_PV(0, 4); ATT_SB();
                    ATT_VLOAD(0, 5); ATT_SB(); ATT_PV(0, 5); ATT_SB();
                    ATT_VLOAD(0, 6); ATT_SB(); ATT_PV(0, 6); ATT_SB();
                    ATT_VLOAD(0, 7); ATT_SB(); ATT_PV(0, 7); ATT_SB();
                    ATT_VLOAD(0, 8); ATT_SB(); ATT_PV(0, 8); ATT_SB();
#undef ATT_VLOAD
#undef ATT_PV
#undef ATT_SB
                }
                float ssq = 0.f;
#pragma unroll
                for (int dt = 0; dt < 4; ++dt) { O[dt] = O[dt] * inv;
                    const v2u ow = (v2u){pk2(O[dt][0], O[dt][1]), pk2(O[dt][2], O[dt][3])};
                    *(v2u*)(CAT + (rbase + q0 + rl) * 1024 + head * 64 + 16 * dt + 4 * g) = ow;
                    const float a = bf_lo(ow.x), b2 = bf_hi(ow.x), c = bf_lo(ow.y), d = bf_hi(ow.y); ssq += (a * a + b2 * b2) + (c * c + d * d); }
                ssq += __shfl_xor(ssq, 16); ssq += __shfl_xor(ssq, 32);
                if (g == 0) SSs[rl * 8 + head] = ssq;
            }
        }
        asm volatile("s_waitcnt vmcnt(0)" ::: "memory");
        __syncthreads();
        { const bf16* OF = (const bf16*)(ws + WS_Y); const bf16* OBk = OF + (size_t)MTOK * 512; const bf16* HG = (const bf16*)(ws + WS_HG);
            const f32x4 w0 = *(const f32x4*)(hg_norm + 8 * l15), w1 = *(const f32x4*)(hg_norm + 8 * l15 + 4);
            const f32x4 n0 = *(const f32x4*)(att_norm + 8 * lane), n1 = *(const f32x4*)(att_norm + 8 * lane + 4);
            v4u la[8], lb[8], lg[8], lc[8];
#pragma unroll
            for (int i = 0; i < 8; ++i) { const size_t row = rbase + q0 + 8 * w + i; const size_t off = row * 512 + 8 * lane;
                la[i] = *(const v4u*)(OF + off); lb[i] = *(const v4u*)(OBk + off); lg[i] = *(const v4u*)(HG + off); lc[i] = *(const v4u*)(CAT + row * 1024 + 8 * lane); }
#pragma unroll
            for (int i = 0; i < 8; ++i) { const int rl = 8 * w + i; const size_t row = rbase + q0 + rl;
                const v4u a = la[i], bb = lb[i], gg = lg[i], ar = lc[i];
                const LAS f32x4* sp = (const LAS f32x4*)(SSs + rl * 8); const f32x4 t0 = sp[0], t1 = sp[1];
                const float rna = __builtin_amdgcn_rsqf((((t0[0] + t0[1]) + (t0[2] + t0[3])) + ((t1[0] + t1[1]) + (t1[2] + t1[3]))) * (1.f / 512.f) + EPS);
                v4u ao; ao.x = pk2(bf_lo(ar.x) * rna * n0[0], bf_hi(ar.x) * rna * n0[1]); ao.y = pk2(bf_lo(ar.y) * rna * n0[2], bf_hi(ar.y) * rna * n0[3]);
                ao.z = pk2(bf_lo(ar.z) * rna * n1[0], bf_hi(ar.z) * rna * n1[1]); ao.w = pk2(bf_lo(ar.w) * rna * n1[2], bf_hi(ar.w) * rna * n1[3]);
                *(v4u*)(CAT + row * 1024 + 8 * lane) = ao;
                float v[8]; v[0] = bf_lo(a.x) + bf_lo(bb.x); v[1] = bf_hi(a.x) + bf_hi(bb.x); v[2] = bf_lo(a.y) + bf_lo(bb.y); v[3] = bf_hi(a.y) + bf_hi(bb.y);
                v[4] = bf_lo(a.z) + bf_lo(bb.z); v[5] = bf_hi(a.z) + bf_hi(bb.z); v[6] = bf_lo(a.w) + bf_lo(bb.w); v[7] = bf_hi(a.w) + bf_hi(bb.w);
                float ss = 0.f;
#pragma unroll
                for (int e2 = 0; e2 < 8; ++e2) ss += v[e2] * v[e2];
                ss = row16_sum(ss);
                const float rn = __builtin_amdgcn_rsqf(ss * (1.f / 128.f) + EPS);
                v4u o; o.x = pk2(v[0] * rn * w0[0] * bf_lo(gg.x), v[1] * rn * w0[1] * bf_hi(gg.x)); o.y = pk2(v[2] * rn * w0[2] * bf_lo(gg.y), v[3] * rn * w0[3] * bf_hi(gg.y));
                o.z = pk2(v[4] * rn * w1[0] * bf_lo(gg.z), v[5] * rn * w1[1] * bf_hi(gg.z)); o.w = pk2(v[6] * rn * w1[2] * bf_lo(gg.w), v[7] * rn * w1[3] * bf_hi(gg.w));
                *(v4u*)(CAT + row * 1024 + 512 + 8 * lane) = o; } }
    }
#undef ATT_PREFETCH
}

__global__ void __launch_bounds__(NTHR, 2) fwd_mega(Params P) {
    extern __shared__ __attribute__((aligned(16))) unsigned char lds_raw[];
    cg::grid_group grid = cg::this_grid();
    LAS unsigned char* lds = (LAS unsigned char*)lds_raw;
    const int tid = threadIdx.x, lane = tid & 63, wave = __builtin_amdgcn_readfirstlane(tid >> 6);
    volatile LAS unsigned* MISC = (volatile LAS unsigned*)(lds + 131072 + 8192);
    if (tid < 16) MISC[tid] = 0u;
    __syncthreads();
    XcdBarrier xbar = xcd_barrier_post((unsigned*)P.ws, MISC + 8);
#define FAST_SYNC() xcd_barrier(xbar)
    const int G = gridDim.x, bid = blockIdx.x;
    const int gw = bid * NWAVES + wave, NGW = G * NWAVES;
    unsigned char* ws = P.ws;
    const float* x = P.in[0];
    bf16* XN = (bf16*)(ws + WS_XN); bf16* Y = (bf16*)(ws + WS_Y); bf16* H = (bf16*)(ws + WS_H);
    float* rope = (float*)(ws + WS_ROPE); float* R2 = (float*)(ws + WS_SS2); unsigned* CNT = (unsigned*)ws; float* XB = (float*)(ws + WS_XB);
    bf16* XN2 = (bf16*)(ws + WS_Y);

    constexpr int I_GU = (D_MODEL / 64) * (D_FF / 32), I_D = (D_FF / 64) * (D_MODEL / 32), I_IN = (D_MODEL / 64) * (IN_WIDTH / 32), I_OUT = (D_MODEL / 64) * (D_MODEL / 32);
    constexpr int NITEMS = 4 * I_GU + 2 * I_D + I_IN + I_OUT;
    LAS float* scr = (LAS float*)(lds + wave * 16384);
    {
#define TRANSPOSE_RANGE(lo_, hi_) do { for (int it = (lo_) + gw; it < (hi_); it += NGW) { int r = it; \
            if (r < I_GU) { transpose_item(P.in[3], D_MODEL, D_FF, (bf16*)(ws + WS_W1GU), 1, scr, r, lane, P.in[1]); continue; } r -= I_GU; \
            if (r < I_GU) { transpose_item(P.in[4], D_MODEL, D_FF, (bf16*)(ws + WS_W1GU), 2, scr, r, lane, P.in[1]); continue; } r -= I_GU; \
            if (r < I_D) { transpose_item(P.in[5], D_FF, D_MODEL, (bf16*)(ws + WS_W1D), 0, scr, r, lane); continue; } r -= I_D; \
            if (r < I_IN) { transpose_item(P.in[8], D_MODEL, IN_WIDTH, (bf16*)(ws + WS_WIN), 0, scr, r, lane, P.in[6]); continue; } r -= I_IN; \
            if (r < I_OUT) { transpose_item(P.in[14], D_MODEL, D_MODEL, (bf16*)(ws + WS_WOUT), 0, scr, r, lane); continue; } r -= I_OUT; \
            if (r < I_GU) { transpose_item(P.in[17], D_MODEL, D_FF, (bf16*)(ws + WS_W2GU), 1, scr, r, lane, P.in[15]); continue; } r -= I_GU; \
            if (r < I_GU) { transpose_item(P.in[18], D_MODEL, D_FF, (bf16*)(ws + WS_W2GU), 2, scr, r, lane, P.in[15]); continue; } r -= I_GU; \
            transpose_item(P.in[19], D_FF, D_MODEL, (bf16*)(ws + WS_W2D), 0, scr, r, lane); } } while (0)
        if (wave < 4) TRANSPOSE_RANGE(0, NITEMS);
        for (int i = bid * NTHR + tid; i < SEQ * 8; i += G * NTHR) { const int pos = i >> 3, j = i & 7;
            const double th = j == 0 ? 1.0 : j == 1 ? 0.19392274474868576 : j == 2 ? 0.03760603093086393 : j == 3 ? 0.007292664737217109 : j == 4 ? 0.001414213562373095 : j == 5 ? 0.0002742481756762073 : j == 6 ? 5.318295896944988e-05 : 1.031338537721246e-05;
            const double ang = (double)pos * th; const double nn = __builtin_rint(ang * 0.15915494309189535); const double r = __builtin_fma(-nn, 2.4492935982947064e-16, __builtin_fma(-nn, 6.283185307179586, ang)); const double r2 = r * r;
            double sn = 1.0, cs = 1.0;
            for (int k = 15; k >= 1; --k) { sn = 1.0 - r2 * sn / (double)((2 * k) * (2 * k + 1)); cs = 1.0 - r2 * cs / (double)((2 * k - 1) * (2 * k)); }
            rope[pos * 16 + j] = (float)cs; rope[pos * 16 + 8 + j] = (float)(r * sn); }
        row_pass2<0>(x, XN, nullptr, nullptr, 0.f, nullptr, R2, gw, NGW, lane);
        if (wave >= 4) TRANSPOSE_RANGE(0, NITEMS);
    }
    if (P.ws == nullptr) grid.sync();
    FAST_SYNC();
    if (tid == 0) *(volatile LAS int*)(lds + 131072 + 4096 + 1024) = -1;
    __syncthreads();
    { pg8::Gemm g{XN, (const bf16*)(ws + WS_W1GU), MTOK, 2 * D_FF, D_MODEL}; pg8::StaticOrder S; S.init(MTOK, 2 * D_FF, G, bid); pg8::EpiSwiGLU E{H, D_FF, R2};
      pg8::gemm_phase<pg8::EpiSwiGLU, pg8::StaticOrder, true, true>(lds, g, S, E);
#ifdef DUP_P1
      __syncthreads(); pg8::gemm_phase<pg8::EpiSwiGLU, pg8::StaticOrder, true, true>(lds, g, S, E);
#endif
    }
    FAST_SYNC();
    { pg8::Gemm g{H, (const bf16*)(ws + WS_W1D), MTOK, D_MODEL, D_FF}; pg8::StaticOrder S; S.init(MTOK, D_MODEL, G, bid);
      pg8::EpiNormRes2 E{XN, nullptr, P.in[2], 0.5f, XB, CNT + 4096, R2};
      pg8::gemm_phase<pg8::EpiNormRes2, pg8::StaticOrder, true, true>(lds, g, S, E); }
    FAST_SYNC();
    if (tid == 0) *(volatile LAS int*)(lds + 131072 + 4096 + 1024) = -1;
    __syncthreads();
    { pg8::Gemm g{XN, (const bf16*)(ws + WS_WIN), MTOK, IN_WIDTH, D_MODEL}; pg8::StaticOrder S; S.init(MTOK, IN_WIDTH, G, bid);
      pg8::EpiMixer E{ws, R2, P.in[11], P.in[12]};
#ifndef NO_MIX
      { LAS float* lbt = (LAS float*)(lds + 131072);
        for (int i = tid; i < 1024; i += NTHR) { const float* lr = (i >> 9) ? P.in[12] : P.in[11]; const int cidx = i & 511; lbt[i] = __builtin_amdgcn_rcpf(1.0f + __expf(lr[512 + cidx] - lr[cidx])); }
        __syncthreads(); }
      pg8::gemm_phase<pg8::EpiMixer, pg8::StaticOrder, true, true>(lds, g, S, E);
#ifdef DUP_P4
      __syncthreads(); pg8::gemm_phase<pg8::EpiMixer, pg8::StaticOrder, true, true>(lds, g, S, E);
#endif
#endif
    }
    FAST_SYNC();
    const int vbid = (G % 8 == 0) ? (bid % 8) * (G / 8) + bid / 8 : bid;
#ifndef NO_SCAN
    scan_phase(lds, ws, G, vbid, tid);
#ifdef DUP_SCAN
    __syncthreads(); scan_phase(lds, ws, G, bid, tid);
#endif
#endif
    FAST_SYNC();
#ifndef NO_ATTN
    attn_phase(lds, ws, P.in[9], P.in[10], P.in[13], G, vbid, tid);
#ifdef DUP_ATTN
    __syncthreads(); attn_phase(lds, ws, P.in[9], P.in[10], P.in[13], G, bid, tid);
#endif
#endif
    FAST_SYNC();
    { pg8::Gemm g{(const bf16*)(ws + WS_KK), (const bf16*)(ws + WS_WOUT), MTOK, D_MODEL, D_MODEL}; pg8::StaticOrder S; S.init(MTOK, D_MODEL, G, bid);
      pg8::EpiNormRes2 E{XN, nullptr, P.in[7], 1.0f, XB + (size_t)MTOK * 4, CNT + 4096 + 256 * 64, R2};
      pg8::gemm_phase<pg8::EpiNormRes2, pg8::StaticOrder, true, true>(lds, g, S, E); }
    FAST_SYNC();
    if (tid == 0) *(volatile LAS int*)(lds + 131072 + 4096 + 1024) = -1;
    __syncthreads();
    { pg8::Gemm g{XN, (const bf16*)(ws + WS_W2GU), MTOK, 2 * D_FF, D_MODEL}; pg8::StaticOrder S; S.init(MTOK, 2 * D_FF, G, bid); pg8::EpiSwiGLU E{H, D_FF, R2};
      pg8::gemm_phase<pg8::EpiSwiGLU, pg8::StaticOrder, true, true>(lds, g, S, E); }
    FAST_SYNC();
    { pg8::Gemm g{H, (const bf16*)(ws + WS_W2D), MTOK, D_MODEL, D_FF}; pg8::StaticOrder S; S.init(MTOK, D_MODEL, G, bid);
      pg8::EpiNormRes2 E{XN, P.out, P.in[16], 0.5f, XB + (size_t)2 * MTOK * 4, CNT + 4096 + 2 * 256 * 64, R2};
      pg8::gemm_phase<pg8::EpiNormRes2, pg8::StaticOrder, true, true>(lds, g, S, E); }
}

extern "C" void kernel_launch(void* const* d_in, const int* in_sizes, int n_in, void* d_out, int out_size, void* d_ws, size_t ws_size, hipStream_t stream) {
    static int grid = 0;
    if (grid == 0) {
        if (n_in != 20 || ws_size < WS_END) { fprintf(stderr, "kernel_launch: unexpected n_in %d / ws %zu\n", n_in, ws_size); grid = -1; return; }
        int dev = 0, cus = 0, per_cu = 0;
        hipGetDevice(&dev); hipDeviceGetAttribute(&cus, hipDeviceAttributeMultiprocessorCount, dev);
        hipFuncSetAttribute((const void*)fwd_mega, hipFuncAttributeMaxDynamicSharedMemorySize, LDS_BYTES);
        hipOccupancyMaxActiveBlocksPerMultiprocessor(&per_cu, (const void*)fwd_mega, NTHR, LDS_BYTES);
        if (per_cu < 1) { fprintf(stderr, "kernel_launch: occupancy query gave %d\n", per_cu); per_cu = 1; }
        grid = cus * 1;
        (void)hipGetLastError();
    }
    if (grid < 0) return;
    if (hipMemsetAsync(d_ws, 0, CTL_BYTES, stream) != hipSuccess) { fprintf(stderr, "memset failed\n"); return; }
    if (hipMemsetAsync((unsigned char*)d_ws + WS_XB, 0xFF, (size_t)3 * MTOK * 4 * sizeof(float), stream) != hipSuccess) { fprintf(stderr, "memset 2 failed\n"); return; }
    Params p{};
    for (int i = 0; i < 20; ++i) p.in[i] = (const float*)d_in[i];
    p.out = (float*)d_out; p.ws = (unsigned char*)d_ws;
    void* args[] = {&p};
    hipError_t e = hipLaunchCooperativeKernel((const void*)fwd_mega, dim3(grid), dim3(NTHR), args, LDS_BYTES, stream);
    if (e != hipSuccess) fprintf(stderr, "cooperative launch failed: %s (grid %d)\n", hipGetErrorString(e), grid);
}
```
